# Optimizing an MI355X kernel written in HIP

```python
import jax
import jax.numpy as jnp
from jax import lax
import numpy as np

D_MODEL = 2048
BATCH = 4
SEQ = 4096
DEPTH = 1

MIX_WIDTH = D_MODEL
ATT_WIDTH = MIX_WIDTH // 2
HGRN_WIDTH = MIX_WIDTH - ATT_WIDTH
HEAD_DIM = 128
N_ATT_HEADS = ATT_WIDTH // HEAD_DIM
N_KV_GROUPS = 2
HEADS_PER_GROUP = N_ATT_HEADS // N_KV_GROUPS
KV_WIDTH = N_KV_GROUPS * HEAD_DIM
CMP_BLOCK = 32
CMP_STRIDE = 16
SEL_BLOCK = 64
N_SEL = 16
WINDOW = 512
Q_BLOCK = 64
FORCE_BONUS = 1.0e4
ROPE_THETA = 10000.0
HGRN_HEAD_DIM = 128
N_HGRN_HEADS = HGRN_WIDTH // HGRN_HEAD_DIM
HGRN_CHUNK = 64
N_EXPERT_GROUPS = 4
EXPERTS_PER_GROUP = 8
N_EXPERTS = N_EXPERT_GROUPS * EXPERTS_PER_GROUP
EXPERT_TOP_K = 2
D_EXPERT = 512
IN_COLS = ATT_WIDTH + 6 * KV_WIDTH + 3 * N_ATT_HEADS + 4 * HGRN_WIDTH
EPS = 1e-6

kernel_name = 'hybrid_nsa_hgrn2_hmoe_block'


def rmsnorm(x, g):
    xf = x.astype(jnp.float32)
    y = xf * lax.rsqrt(jnp.mean(xf * xf, axis=-1, keepdims=True) + EPS)
    return (y * g.astype(jnp.float32)).astype(x.dtype)


def rope(t, pos):
    d = t.shape[-1]
    inv_freq = ROPE_THETA ** (-jnp.arange(0, d, 2, dtype=jnp.float32) / d)
    ang = pos.astype(jnp.float32)[:, :, None, None] * inv_freq
    cos, sin = jnp.cos(ang), jnp.sin(ang)
    tf = t.astype(jnp.float32)
    t1, t2 = tf[..., : d // 2], tf[..., d // 2:]
    return jnp.concatenate([t1 * cos - t2 * sin, t2 * cos + t1 * sin], axis=-1).astype(t.dtype)


def masked_softmax(s, mask):
    s = jnp.where(mask, s.astype(jnp.float32), -jnp.inf)
    m = jnp.max(s, axis=-1, keepdims=True)
    m = jnp.where(jnp.isfinite(m), m, 0.0)
    p = jnp.exp(s - m)
    return p / jnp.maximum(jnp.sum(p, axis=-1, keepdims=True), 1e-30)


def compress_blocks(t, pos_emb, w1, w2):
    B, S, G, d = t.shape
    nc = (S - CMP_BLOCK) // CMP_STRIDE + 1
    idx = (jnp.arange(nc) * CMP_STRIDE)[:, None] + jnp.arange(CMP_BLOCK)[None, :]
    blk = t[:, idx] + pos_emb[None, None, :, None, :]
    blk = blk.transpose(0, 1, 3, 2, 4).reshape(B, nc, G, CMP_BLOCK * d)
    return jax.nn.silu(blk @ w1) @ w2


def nsa_attention(q, k_cmp, v_cmp, k_slc, v_slc, k_win, v_win, gate_logits, pos,
                  pe_k, w1_k, w2_k, pe_v, w1_v, w2_v):
    B, S = q.shape[:2]
    G, H, d = N_KV_GROUPS, HEADS_PER_GROUP, HEAD_DIM
    scale = d ** -0.5
    t_idx = jnp.arange(S)
    qg = rope(q, pos).reshape(B, S, G, H, d)
    k_cmp, k_slc, k_win = rope(k_cmp, pos), rope(k_slc, pos), rope(k_win, pos)

    kc = compress_blocks(k_cmp, pe_k, w1_k, w2_k)
    vc = compress_blocks(v_cmp, pe_v, w1_v, w2_v)
    nc = kc.shape[1]
    c_start = jnp.arange(nc) * CMP_STRIDE
    c_mask = (c_start + CMP_BLOCK - 1)[None, :] <= t_idx[:, None]
    s_c = jnp.einsum('bsghd,bcgd->bghsc', qg, kc) * scale
    p_c = masked_softmax(s_c, c_mask)
    o_cmp = jnp.einsum('bghsc,bcgd->bsghd', p_c, vc.astype(jnp.float32))

    nsel = S // SEL_BLOCK
    n_top = min(N_SEL, nsel)
    j_start = jnp.arange(nsel) * SEL_BLOCK
    overlap = ((c_start[:, None] < j_start[None, :] + SEL_BLOCK)
               & (c_start[:, None] + CMP_BLOCK > j_start[None, :])).astype(jnp.float32)
    imp = jnp.einsum('bghsc,cj->bgsj', p_c, overlap)
    cur = (t_idx // SEL_BLOCK)[:, None]
    jj = jnp.arange(nsel)[None, :]
    forced = (jj == 0) | (jj == cur) | (jj == cur - 1)
    imp = jnp.where(jj <= cur, imp + jnp.where(forced, FORCE_BONUS, 0.0), -jnp.inf)
    _, sel_idx = lax.top_k(imp, n_top)

    kb = k_slc.reshape(B, nsel, SEL_BLOCK, G, d).transpose(0, 3, 1, 2, 4)
    vb = v_slc.reshape(B, nsel, SEL_BLOCK, G, d).transpose(0, 3, 1, 2, 4)
    kw = jnp.pad(k_win, ((0, 0), (WINDOW, 0), (0, 0), (0, 0)))
    vw = jnp.pad(v_win, ((0, 0), (WINDOW, 0), (0, 0), (0, 0)))
    b_ix = jnp.arange(B)[:, None, None, None]
    g_ix = jnp.arange(G)[None, :, None, None]
    in_blk = jnp.arange(SEL_BLOCK)
    w_off = jnp.arange(Q_BLOCK + WINDOW) - WINDOW

    def query_block(q0):
        tq = q0 + jnp.arange(Q_BLOCK)
        qb = lax.dynamic_slice_in_dim(qg, q0, Q_BLOCK, axis=1)
        ib = lax.dynamic_slice_in_dim(sel_idx, q0, Q_BLOCK, axis=2)
        ks = kb[b_ix, g_ix, ib]
        vs = vb[b_ix, g_ix, ib]
        s_s = jnp.einsum('bqghd,bgqnkd->bghqnk', qb, ks) * scale
        kpos = ib[..., None] * SEL_BLOCK + in_blk
        m_s = (kpos <= tq[None, None, :, None, None]).reshape(B, G, 1, Q_BLOCK, -1)
        p_s = masked_softmax(s_s.reshape(B, G, H, Q_BLOCK, -1), m_s).reshape(s_s.shape)
        o_s = jnp.einsum('bghqnk,bgqnkd->bqghd', p_s, vs.astype(jnp.float32))
        kwb = lax.dynamic_slice_in_dim(kw, q0, Q_BLOCK + WINDOW, axis=1)
        vwb = lax.dynamic_slice_in_dim(vw, q0, Q_BLOCK + WINDOW, axis=1)
        kpos_w = q0 + w_off
        dist = tq[:, None] - kpos_w[None, :]
        m_w = (dist >= 0) & (dist < WINDOW) & (kpos_w[None, :] >= 0)
        s_w = jnp.einsum('bqghd,bkgd->bghqk', qb, kwb) * scale
        p_w = masked_softmax(s_w, m_w)
        o_w = jnp.einsum('bghqk,bkgd->bqghd', p_w, vwb.astype(jnp.float32))
        return o_s, o_w

    o_s, o_w = lax.map(query_block, jnp.arange(S // Q_BLOCK) * Q_BLOCK)
    o_s = o_s.transpose(1, 0, 2, 3, 4, 5).reshape(B, S, G, H, d)
    o_w = o_w.transpose(1, 0, 2, 3, 4, 5).reshape(B, S, G, H, d)
    gt = jax.nn.sigmoid(gate_logits.astype(jnp.float32)).reshape(B, S, G, H, 3)
    o = gt[..., 0:1] * o_cmp + gt[..., 1:2] * o_s + gt[..., 2:3] * o_w
    return o.reshape(B, S, ATT_WIDTH).astype(q.dtype)


def hgrn2(q, f_logit, i, g, lb, g_norm):
    B, S, H, dk = q.shape
    nch = S // HGRN_CHUNK
    lb = lb.astype(jnp.float32).reshape(H, dk)
    f = lb + (1.0 - lb) * jax.nn.sigmoid(f_logit.astype(jnp.float32))
    log_f = jnp.log(f)
    k = 1.0 - f
    qf = jax.nn.silu(q.astype(jnp.float32))
    v = i.astype(jnp.float32)

    def to_chunks(t):
        return t.reshape(B, nch, HGRN_CHUNK, H, -1).transpose(1, 0, 3, 2, 4)

    causal = jnp.tril(jnp.ones((HGRN_CHUNK, HGRN_CHUNK), dtype=bool))

    def step(state, inp):
        qc, kc, vc, lc = inp
        bcum = jnp.cumsum(lc, axis=2)
        rel = jnp.where(causal[:, :, None], bcum[:, :, :, None, :] - bcum[:, :, None, :, :], -jnp.inf)
        a = jnp.einsum('bhid,bhjd,bhijd->bhij', qc, kc, jnp.exp(rel))
        o = (jnp.einsum('bhij,bhje->bhie', a, vc)
             + jnp.einsum('bhid,bhde->bhie', qc * jnp.exp(bcum), state))
        blast = bcum[:, :, -1:, :]
        state = (jnp.exp(blast[:, :, 0, :, None]) * state
                 + jnp.einsum('bhjd,bhje->bhde', kc * jnp.exp(blast - bcum), vc))
        return state, o

    s0 = jnp.zeros((B, H, dk, v.shape[-1]), jnp.float32)
    _, o = lax.scan(step, s0, (to_chunks(qf), to_chunks(k), to_chunks(v), to_chunks(log_f)))
    o = o.transpose(1, 0, 3, 2, 4).reshape(B, S, H, -1)
    o = o * lax.rsqrt(jnp.mean(o * o, axis=-1, keepdims=True) + EPS) * g_norm.astype(jnp.float32).reshape(H, -1)
    o = o * jax.nn.silu(g.astype(jnp.float32))
    return o.reshape(B, S, HGRN_WIDTH).astype(q.dtype)


def hybrid_mixer(h, pos, w_in, w_out, pe_k, w1_k, w2_k, pe_v, w1_v, w2_v, lb, g_norm):
    B, S, _ = h.shape
    proj = h @ w_in
    sizes = [ATT_WIDTH] + [KV_WIDTH] * 6 + [3 * N_ATT_HEADS] + [HGRN_WIDTH] * 4
    cuts = [int(v) for v in np.cumsum(sizes)[:-1]]
    parts = jnp.split(proj, cuts, axis=-1)
    q = parts[0].reshape(B, S, N_ATT_HEADS, HEAD_DIM)
    k_c, v_c, k_s, v_s, k_w, v_w = [p.reshape(B, S, N_KV_GROUPS, HEAD_DIM) for p in parts[1:7]]
    gate_logits = parts[7].reshape(B, S, N_ATT_HEADS, 3)
    hq, hf, hi, hg = [p.reshape(B, S, N_HGRN_HEADS, HGRN_HEAD_DIM) for p in parts[8:]]
    o_att = nsa_attention(q, k_c, v_c, k_s, v_s, k_w, v_w, gate_logits, pos,
                          pe_k, w1_k, w2_k, pe_v, w1_v, w2_v)
    o_rec = hgrn2(hq, hf, hi, hg, lb, g_norm)
    return jnp.concatenate([o_att, o_rec], axis=-1) @ w_out


def hier_moe(h, w_group, b_group, w_router, b_router, w_gate, w_up, w_down):
    B, S, D = h.shape
    T = B * S
    ht = h.reshape(T, D)
    lg = (ht @ w_group + b_group).astype(jnp.float32)
    pg = jax.nn.softmax(lg, axis=-1)
    _, gsel = lax.top_k(lg, 1)
    pg_sel = jnp.take_along_axis(pg, gsel, axis=-1)
    le = (ht @ w_router + b_router).astype(jnp.float32).reshape(T, N_EXPERT_GROUPS, EXPERTS_PER_GROUP)
    le_sel = jnp.take_along_axis(le, gsel[:, :, None], axis=1)[:, 0]
    pe = jax.nn.softmax(le_sel, axis=-1)
    topv, topi = lax.top_k(pe, EXPERT_TOP_K)
    topv = topv / jnp.sum(topv, axis=-1, keepdims=True)
    w_in_grp = jnp.sum(jax.nn.one_hot(topi, EXPERTS_PER_GROUP, dtype=jnp.float32) * topv[..., None], axis=1)
    cw = (jax.nn.one_hot(gsel[:, 0], N_EXPERT_GROUPS, dtype=jnp.float32)[:, :, None]
          * (w_in_grp * pg_sel)[:, None, :])
    y = jnp.zeros((T, D), jnp.float32)
    for gi in range(N_EXPERT_GROUPS):
        hid = (jax.nn.silu(jnp.einsum('td,edf->tef', ht, w_gate[gi]))
               * jnp.einsum('td,edf->tef', ht, w_up[gi]))
        y = y + jnp.einsum('tef,efd->td', hid * cw[:, gi, :, None], w_down[gi])
    return y.reshape(B, S, D).astype(h.dtype)


def setup_inputs(seed: int = 0) -> dict:
    key = jax.random.key(seed)
    ks = jax.random.split(key, 32)
    f32 = jnp.float32

    def nrm(k, shape, scale):
        return jax.random.normal(k, shape, f32) * scale

    L, D = DEPTH, D_MODEL
    offset = jax.random.randint(ks[2], (BATCH, 1), 0, 1024, dtype=jnp.int32)
    return {
        'x': nrm(ks[0], (BATCH, SEQ, D), 1.0),
        'c': nrm(ks[1], (BATCH, D), 1.0),
        'positions': offset + jnp.arange(SEQ, dtype=jnp.int32)[None, :],
        'w_ada': nrm(ks[3], (L, D, 6 * D), 0.5 * D ** -0.5),
        'b_ada': nrm(ks[4], (L, 6 * D), 0.02),
        'g_pre_mix': 1.0 + nrm(ks[5], (L, D), 0.05),
        'g_post_mix': 1.0 + nrm(ks[6], (L, D), 0.05),
        'g_pre_ffn': 1.0 + nrm(ks[7], (L, D), 0.05),
        'g_post_ffn': 1.0 + nrm(ks[8], (L, D), 0.05),
        'w_in': nrm(ks[9], (L, D, IN_COLS), D ** -0.5),
        'w_out': nrm(ks[10], (L, MIX_WIDTH, D), MIX_WIDTH ** -0.5),
        'cmp_pe_k': nrm(ks[11], (L, CMP_BLOCK, HEAD_DIM), 0.02),
        'cmp_w1_k': nrm(ks[12], (L, CMP_BLOCK * HEAD_DIM, HEAD_DIM), (CMP_BLOCK * HEAD_DIM) ** -0.5),
        'cmp_w2_k': nrm(ks[13], (L, HEAD_DIM, HEAD_DIM), HEAD_DIM ** -0.5),
        'cmp_pe_v': nrm(ks[14], (L, CMP_BLOCK, HEAD_DIM), 0.02),
        'cmp_w1_v': nrm(ks[15], (L, CMP_BLOCK * HEAD_DIM, HEAD_DIM), (CMP_BLOCK * HEAD_DIM) ** -0.5),
        'cmp_w2_v': nrm(ks[16], (L, HEAD_DIM, HEAD_DIM), HEAD_DIM ** -0.5),
        'hgrn_lb_logits': nrm(ks[17], (L + 1, HGRN_WIDTH), 0.5),
        'hgrn_g_norm': 1.0 + nrm(ks[18], (L, HGRN_WIDTH), 0.05),
        'w_group': nrm(ks[19], (L, D, N_EXPERT_GROUPS), D ** -0.5),
        'b_group': nrm(ks[20], (L, N_EXPERT_GROUPS), 0.01),
        'w_router': nrm(ks[21], (L, D, N_EXPERTS), D ** -0.5),
        'b_router': nrm(ks[22], (L, N_EXPERTS), 0.01),
        'w_gate': nrm(ks[23], (L, N_EXPERT_GROUPS, EXPERTS_PER_GROUP, D, D_EXPERT), D ** -0.5),
        'w_up': nrm(ks[24], (L, N_EXPERT_GROUPS, EXPERTS_PER_GROUP, D, D_EXPERT), D ** -0.5),
        'w_down': nrm(ks[25], (L, N_EXPERT_GROUPS, EXPERTS_PER_GROUP, D_EXPERT, D), D_EXPERT ** -0.5),
    }


def reference(x, c, positions, w_ada, b_ada, g_pre_mix, g_post_mix, g_pre_ffn, g_post_ffn,
              w_in, w_out, cmp_pe_k, cmp_w1_k, cmp_w2_k, cmp_pe_v, cmp_w1_v, cmp_w2_v,
              hgrn_lb_logits, hgrn_g_norm, w_group, b_group, w_router, b_router,
              w_gate, w_up, w_down):
    lb_table = jnp.cumsum(jax.nn.softmax(hgrn_lb_logits.astype(jnp.float32), axis=0), axis=0)
    for l in range(DEPTH):
        mod = (jax.nn.silu(c) @ w_ada[l] + b_ada[l])[:, None, :]
        sh1, sc1, gt1, sh2, sc2, gt2 = jnp.split(mod, 6, axis=-1)
        h = rmsnorm(x, g_pre_mix[l]) * (1.0 + sc1) + sh1
        y = hybrid_mixer(h, positions, w_in[l], w_out[l], cmp_pe_k[l], cmp_w1_k[l], cmp_w2_k[l],
                         cmp_pe_v[l], cmp_w1_v[l], cmp_w2_v[l], lb_table[l], hgrn_g_norm[l])
        x = x + gt1 * rmsnorm(y, g_post_mix[l])
        h = rmsnorm(x, g_pre_ffn[l]) * (1.0 + sc2) + sh2
        y = hier_moe(h, w_group[l], b_group[l], w_router[l], b_router[l], w_gate[l], w_up[l], w_down[l])
        x = x + gt2 * rmsnorm(y, g_post_ffn[l])
    return x
```

```cpp
#include <hip/hip_runtime.h>
#include <hip/hip_bf16.h>
#include <cstdio>
#include <cstdint>
#define MK_SWEEP3 1
#define MK_SWZ15 1
namespace pg8 {
#define PG8_LAS __attribute__((address_space(3)))
typedef unsigned short bf16_t;
typedef short bf16x8 __attribute__((ext_vector_type(8)));
typedef float f32x4 __attribute__((ext_vector_type(4)));
typedef unsigned u32x4 __attribute__((ext_vector_type(4)));
constexpr int BM = 256, BK = 64, HALF = 128, HTB = HALF * BK * 2  , STAGE_BYTES = 8 * HTB, NXCD = 8, WGM = 8;

__host__ __device__ __forceinline__ int lds_byte(int r, int c) { const int st = (r >> 4) * 2 + (c >> 5), rr = r & 15, cc = c & 31, ob = rr * 64 + cc * 2; return st * 1024 + (ob ^ (((ob >> 9) & 1) << 5)); }
__host__ __device__ __forceinline__ void stage_rc(int b, int& R, int& C) { const int st = b / 1024, sb = b % 1024, swz = sb ^ (((sb >> 9) & 1) << 5); R = (st >> 1) * 16 + swz / 64; C = (st & 1) * 32 + (swz % 64) / 2; }
__host__ __device__ __forceinline__ int perm32(int rho) { const int n = rho >> 4, i = rho & 15; return 8 * (i >> 2) + 4 * n + (i & 3); }

struct Unit { int pm, pn; };
struct Gemm { const bf16_t* A; const bf16_t* Bt; int M, N, K; };

struct StaticOrder {
    int nM, nN, nwg, G, c;
    __host__ __device__ void init(int M, int N, int G_, int c_) { nM = M / BM; nN = N / BM; nwg = nM * nN; G = G_; c = c_; }
    __host__ __device__ bool next(int i, Unit& u) const {
        const long L = (long)i * G + c; if (L >= nwg) return false;
        int wgid = (int)L; { const int q = nwg / NXCD, r = nwg % NXCD, xcd = wgid % NXCD, off = wgid / NXCD; wgid = (xcd < r ? xcd * (q + 1) : r * (q + 1) + (xcd - r) * q) + off; }
        const int nig = WGM * nN, gid = wgid / nig, fm = gid * WGM, gsz = (nM - fm) < WGM ? (nM - fm) : WGM;
        u.pm = fm + ((wgid % nig) % gsz); u.pn = (wgid % nig) / gsz; return true;
    }
    __device__ __forceinline__ void a_ready(const Unit&) const {}
    __device__ __forceinline__ void done(const Unit&) const {}
    __device__ __forceinline__ int arow(const Unit& u, int r) const { return u.pm * BM + r; }
    __device__ __forceinline__ bool half(const Unit&) const { return false; }
};
__device__ __forceinline__ unsigned cvt_pk_bf16(float lo, float hi) { unsigned r; asm volatile("v_cvt_pk_bf16_f32 %0, %1, %2" : "=v"(r) : "v"(lo), "v"(hi)); return r; }
struct EpiBf16 {
    static constexpr bool PERM = true, AFTER_DRAIN = false;
    bf16_t* O; int ldc; int pnmask;
    __device__ __forceinline__ void operator()(const f32x4 (&acc)[2][2][4][2], const Unit& u, int wr, int wc, int fr, int fq) const {
        const int row0 = u.pm * BM + wr * 64 + fr; const int col0 = (u.pn & pnmask) * BM + wc * 32 + 8 * fq;
#pragma unroll
        for (int ai = 0; ai < 2; ++ai)
#pragma unroll
            for (int m = 0; m < 4; ++m) { bf16_t* rowp = O + (size_t)(row0 + ai * HALF + m * 16) * ldc + col0;
#pragma unroll
                for (int bj = 0; bj < 2; ++bj) { const f32x4 v0 = acc[ai][bj][m][0], v1 = acc[ai][bj][m][1];
                    u32x4 w; w.x = cvt_pk_bf16(v0[0], v0[1]); w.y = cvt_pk_bf16(v0[2], v0[3]); w.z = cvt_pk_bf16(v1[0], v1[1]); w.w = cvt_pk_bf16(v1[2], v1[3]);
                    *(u32x4*)(rowp + bj * HALF) = w; } }
    }
};
struct EpiProj {
    static constexpr bool PERM = true, AFTER_DRAIN = false;
    bf16_t* O; int ldc; unsigned ropemask; const float* cosT; const float* sinT;
    __device__ __forceinline__ void operator()(const f32x4 (&acc)[2][2][4][2], const Unit& u, int wr, int wc, int fr, int fq) const {
        const int row0 = u.pm * BM + wr * 64 + fr; const int col0 = u.pn * BM + wc * 32 + 8 * fq; const bool rope = (ropemask >> u.pn) & 1u; const int kk = 4 * wc + fq;
#pragma unroll
        for (int ai = 0; ai < 2; ++ai)
#pragma unroll
            for (int m = 0; m < 4; ++m) { const int row = row0 + ai * HALF + m * 16; bf16_t* rowp = O + (size_t)row * ldc + col0;
                f32x4 c = {1.f, 1.f, 1.f, 1.f}, s = {0.f, 0.f, 0.f, 0.f};
                if (rope) { c = *(const f32x4*)(cosT + (size_t)row * 64 + 4 * kk); s = *(const f32x4*)(sinT + (size_t)row * 64 + 4 * kk); }
#pragma unroll
                for (int bj = 0; bj < 2; ++bj) { const f32x4 a0 = acc[ai][bj][m][0], a1 = acc[ai][bj][m][1]; const f32x4 v0 = a0 * c - a1 * s, v1 = a1 * c + a0 * s;
                    u32x4 w; w.x = cvt_pk_bf16(v0[0], v0[1]); w.y = cvt_pk_bf16(v0[2], v0[3]); w.z = cvt_pk_bf16(v1[0], v1[1]); w.w = cvt_pk_bf16(v1[2], v1[3]);
                    *(u32x4*)(rowp + bj * HALF) = w; } }
    }
};
struct EpiGateUp {
    static constexpr bool PERM = true, AFTER_DRAIN = false;
    bf16_t* H; const float* rwe; const PG8_LAS int* toff;
    __device__ __forceinline__ void operator()(const f32x4 (&acc)[2][2][4][2], const Unit& u, int wr, int wc, int fr, int fq) const {
        const int e = u.pn >> 2; const float* rwp = rwe + (size_t)e * 16384 + (u.pm - toff[e]) * BM;
        const int lrow0 = wr * 64 + fr; const int col0 = (u.pn & 3) * 128 + wc * 32 + 8 * fq;
#pragma unroll
        for (int ai = 0; ai < 2; ++ai)
#pragma unroll
            for (int m = 0; m < 4; ++m) { const int lrow = lrow0 + ai * HALF + m * 16; const float w = rwp[lrow]; float h[8];
#pragma unroll
                for (int n = 0; n < 2; ++n)
#pragma unroll
                    for (int e2 = 0; e2 < 4; ++e2) { const float g = acc[ai][0][m][n][e2], up = acc[ai][1][m][n][e2];
                        h[n * 4 + e2] = g * __builtin_amdgcn_rcpf(1.0f + __expf(-g)) * up * w; }
                u32x4 o; o.x = cvt_pk_bf16(h[0], h[1]); o.y = cvt_pk_bf16(h[2], h[3]); o.z = cvt_pk_bf16(h[4], h[5]); o.w = cvt_pk_bf16(h[6], h[7]);
                *(u32x4*)(H + (size_t)(u.pm * BM + lrow) * 512 + col0) = o; }
    }
};
struct MoeOrder {
    const PG8_LAS int* t; const int* rowtok; int npt, G, c;
    __device__ __forceinline__ bool next(int i, Unit& u) const {
        const long L = (long)i * G + c; const int ntiles = t[32]; if (L >= (long)ntiles * npt) return false;
        const int ti = t[96 + (int)(L / npt)], p = (int)(L % npt);
        u.pm = ti; u.pn = t[256 + ti] * npt + p; return true;
    }
    __device__ __forceinline__ void a_ready(const Unit&) const {}
    __device__ __forceinline__ void done(const Unit&) const {}
    __device__ __forceinline__ int arow(const Unit& u, int r) const { const int e = u.pn / npt; const int q = (u.pm - t[e]) * BM + r; return q < t[48 + e] ? rowtok[(size_t)e * 16384 + q] : 0; }
    __device__ __forceinline__ bool half(const Unit& u) const { const int e = u.pn / npt; return t[48 + e] - (u.pm - t[e]) * BM <= HALF; }
};
template <class Epi, class Sched, bool ALIGN_EPI = false, bool SP2 = false, bool GATHER = false>
__device__ __forceinline__ void gemm_phase(PG8_LAS unsigned char* lds, const Gemm g, const Sched& S, const Epi& E) {
    const int tid = threadIdx.x, wid = __builtin_amdgcn_readfirstlane(tid >> 6), lane = tid & 63, wr = wid >> 2, wc = wid & 3, fr = lane & 15, fq = lane >> 4;
    const int K = g.K, nt = K / BK;
    unsigned voffA[2], voffB[2];
#pragma unroll
    for (int i = 0; i < 2; ++i) { int R, C; stage_rc(tid * 16 + i * 8192, R, C); const int Rb = Epi::PERM ? ((R & ~31) + perm32(R & 31)) : R;
        voffA[i] = (unsigned)(R * K + C) * 2u; voffB[i] = (unsigned)(Rb * K + C) * 2u; }
    unsigned cv0[2] = {0u, 0u}, cv1[2] = {0u, 0u}, nv0[2] = {0u, 0u}, nv1[2] = {0u, 0u}; int gR[2] = {0, 0}, gC[2] = {0, 0};
    if constexpr (GATHER) {
#pragma unroll
        for (int i = 0; i < 2; ++i) stage_rc(tid * 16 + i * 8192, gR[i], gC[i]); }
#define PG8_GVOFF(dst0, dst1, un) do { _Pragma("unroll") for (int _i = 0; _i < 2; ++_i) { dst0[_i] = (unsigned)(S.arow(un, gR[_i]) * K + gC[_i]) * 2u; dst1[_i] = (unsigned)(S.arow(un, HALF + gR[_i]) * K + gC[_i]) * 2u; } } while (0)
    const size_t kstep = (size_t)(BK * 2);
    const size_t hstep = (size_t)HALF * K * 2;
    const size_t tstep = 2 * hstep;
    const unsigned ldsw = (unsigned)wid * 1024u;
    const int aoff = lds_byte(wr * 64 + fr, fq * 8), boff = lds_byte(wc * 32 + fr, fq * 8);
#define PG8_SA(b, h) (((b) * 2 + (h)) * HTB)
#define PG8_SB(b, h) ((4 + (b) * 2 + (h)) * HTB)
#define PG8_STAGE(bufoff, gbase, voff) do { _Pragma("unroll") for (int _i = 0; _i < 2; ++_i) \
        __builtin_amdgcn_global_load_lds((const unsigned*)((const char*)(gbase) + (voff)[_i]), (PG8_LAS unsigned*)(lds + (bufoff) + ldsw + _i * 8192), 16, 0, 0); } while (0)
#define PG8_LDA(dst, b, h) do { _Pragma("unroll") for (int m = 0; m < 4; ++m) _Pragma("unroll") for (int k = 0; k < 2; ++k) dst[m][k] = *(const PG8_LAS bf16x8*)(lds + PG8_SA(b, h) + aoff + m * 2048 + k * 1024); } while (0)
#define PG8_LDB(dst, b, h) do { _Pragma("unroll") for (int n = 0; n < 2; ++n) _Pragma("unroll") for (int k = 0; k < 2; ++k) dst[n][k] = *(const PG8_LAS bf16x8*)(lds + PG8_SB(b, h) + boff + n * 2048 + k * 1024); } while (0)
#define PG8_MMA(ai, bj, At, Bt) do { __builtin_amdgcn_s_setprio(1); _Pragma("unroll") for (int m = 0; m < 4; ++m) _Pragma("unroll") for (int n = 0; n < 2; ++n) _Pragma("unroll") for (int k = 0; k < 2; ++k) \
        acc[ai][bj][m][n] = __builtin_amdgcn_mfma_f32_16x16x32_bf16(Bt[n][k], At[m][k], acc[ai][bj][m][n], 0, 0, 0); __builtin_amdgcn_s_setprio(0); } while (0)
#define PG8_WAIT_V(n) asm volatile("s_waitcnt vmcnt(" #n ")" ::: "memory")
#define PG8_WAIT_L(n) asm volatile("s_waitcnt lgkmcnt(" #n ")" ::: "memory")
#define PG8_BAR __builtin_amdgcn_s_barrier()
#define PG8_SCHED __builtin_amdgcn_sched_barrier(0)
    Unit cur, nxt; int ui = 0;
    if (!S.next(0, cur)) return;
    f32x4 acc[2][2][4][2];
#pragma unroll
    for (int a = 0; a < 2; ++a)
#pragma unroll
        for (int b = 0; b < 2; ++b)
#pragma unroll
            for (int m = 0; m < 4; ++m)
#pragma unroll
                for (int n = 0; n < 2; ++n) acc[a][b][m][n] = (f32x4){0.f, 0.f, 0.f, 0.f};
    bf16x8 At[4][2], B0[2][2], B1[2][2];
    const char* cA = (const char*)g.A + (GATHER ? (size_t)0 : (size_t)cur.pm * tstep); const char* cB = (const char*)g.Bt + (size_t)cur.pn * tstep;
    const size_t ahstep = GATHER ? (size_t)0 : hstep;
    S.a_ready(cur);
    if constexpr (GATHER) { PG8_GVOFF(cv0, cv1, cur); }
    static_assert(!GATHER || SP2, "GATHER is wired into the SP2 loop only");
#define PG8_C0 (GATHER ? cv0 : voffA)
#define PG8_C1 (GATHER ? cv1 : voffA)
#define PG8_W0 (GATHER ? wa0 : voffA)
#define PG8_W1 (GATHER ? wa1 : voffA)
    if constexpr (SP2) {
        PG8_STAGE(PG8_SB(0, 0), cB, voffB); PG8_STAGE(PG8_SB(0, 1), cB + hstep, voffB); PG8_STAGE(PG8_SA(0, 0), cA, PG8_C0); PG8_STAGE(PG8_SA(0, 1), cA + ahstep, PG8_C1);
        if (wr == 1) PG8_BAR;
        PG8_WAIT_V(2); PG8_BAR;
        PG8_STAGE(PG8_SB(1, 0), cB + kstep, voffB); PG8_STAGE(PG8_SA(1, 0), cA + kstep, PG8_C0); PG8_STAGE(PG8_SB(1, 1), cB + hstep + kstep, voffB);
        PG8_WAIT_V(6); PG8_BAR;
    } else {
        PG8_STAGE(PG8_SB(0, 0), cB, voffB); PG8_STAGE(PG8_SA(0, 0), cA, voffA); PG8_STAGE(PG8_SB(0, 1), cB + hstep, voffB); PG8_STAGE(PG8_SA(0, 1), cA + hstep, voffA);
        if (wr == 1) PG8_BAR;
        PG8_WAIT_V(4); PG8_BAR;
        PG8_STAGE(PG8_SB(1, 0), cB + kstep, voffB); PG8_STAGE(PG8_SA(1, 0), cA + kstep, voffA); PG8_STAGE(PG8_SB(1, 1), cB + hstep + kstep, voffB);
        PG8_WAIT_V(6); PG8_BAR;
    }
    for (;;) {
        const bool has_next = S.next(ui + 1, nxt);
        const char* nA = (has_next && !GATHER) ? (const char*)g.A + (size_t)nxt.pm * tstep : cA; const char* nB = has_next ? (const char*)g.Bt + (size_t)nxt.pn * tstep : cB;
        if constexpr (GATHER) { if (has_next) { PG8_GVOFF(nv0, nv1, nxt); } else { nv0[0] = cv0[0]; nv0[1] = cv0[1]; nv1[0] = cv1[0]; nv1[1] = cv1[1]; } }
        for (int t = 0; t < nt; t += 2) {
            const bool last = (t == nt - 2);
            const char* a1 = cA + (size_t)(t + 1) * kstep;
            const char* a2 = last ? nA : cA + (size_t)(t + 2) * kstep; const char* b2 = last ? nB : cB + (size_t)(t + 2) * kstep;
            const char* a3 = a2 + kstep; const char* b3 = b2 + kstep;
            if (last && has_next) S.a_ready(nxt);
            unsigned wa0[2] = {0u, 0u}, wa1[2] = {0u, 0u};
            if constexpr (GATHER) { wa0[0] = last ? nv0[0] : cv0[0]; wa0[1] = last ? nv0[1] : cv0[1]; wa1[0] = last ? nv1[0] : cv1[0]; wa1[1] = last ? nv1[1] : cv1[1]; }
            if constexpr (SP2) {
            PG8_LDB(B0, 0, 0); PG8_LDB(B1, 0, 1); PG8_SCHED; PG8_LDA(At, 0, 0); PG8_STAGE(PG8_SA(1, 1), a1 + ahstep, PG8_C1);
            PG8_WAIT_V(8); PG8_WAIT_L(0); PG8_BAR; PG8_MMA(0, 0, At, B0); PG8_MMA(0, 1, At, B1); PG8_BAR; PG8_SCHED;
            PG8_LDA(At, 0, 1); PG8_STAGE(PG8_SB(0, 0), b2, voffB); PG8_STAGE(PG8_SB(0, 1), b2 + hstep, voffB); PG8_STAGE(PG8_SA(0, 0), a2, PG8_W0);
            PG8_WAIT_V(8); PG8_WAIT_L(0); PG8_BAR; PG8_MMA(1, 0, At, B0); PG8_MMA(1, 1, At, B1); PG8_BAR; PG8_SCHED;
            PG8_LDB(B0, 1, 0); PG8_LDB(B1, 1, 1); PG8_SCHED; PG8_LDA(At, 1, 0); PG8_STAGE(PG8_SA(0, 1), a2 + ahstep, PG8_W1);
            PG8_WAIT_V(8); PG8_WAIT_L(0); PG8_BAR; PG8_MMA(0, 0, At, B0); PG8_MMA(0, 1, At, B1); PG8_BAR; PG8_SCHED;
            PG8_LDA(At, 1, 1); PG8_STAGE(PG8_SB(1, 0), b3, voffB); PG8_STAGE(PG8_SB(1, 1), b3 + hstep, voffB); PG8_STAGE(PG8_SA(1, 0), a3, PG8_W0);
            PG8_WAIT_V(8); PG8_WAIT_L(0); PG8_BAR; PG8_MMA(1, 0, At, B0); PG8_MMA(1, 1, At, B1); PG8_BAR; PG8_SCHED;
            } else {
            PG8_LDB(B0, 0, 0); PG8_SCHED; PG8_LDA(At, 0, 0); PG8_STAGE(PG8_SA(1, 1), a1 + hstep, voffA);
            PG8_WAIT_L(8); PG8_BAR; PG8_WAIT_L(0); PG8_MMA(0, 0, At, B0); PG8_BAR; PG8_SCHED;
            PG8_LDB(B1, 0, 1); PG8_STAGE(PG8_SB(0, 0), b2, voffB);
            PG8_BAR; PG8_WAIT_L(0); PG8_MMA(0, 1, At, B1); PG8_BAR;
            PG8_LDA(At, 0, 1); PG8_STAGE(PG8_SA(0, 0), a2, voffA);
            PG8_BAR; PG8_WAIT_L(0); PG8_MMA(1, 0, At, B0); PG8_BAR; PG8_SCHED;
            PG8_STAGE(PG8_SB(0, 1), b2 + hstep, voffB);
            PG8_WAIT_V(6); PG8_BAR; PG8_MMA(1, 1, At, B1); PG8_BAR;
            PG8_LDB(B0, 1, 0); PG8_SCHED; PG8_LDA(At, 1, 0); PG8_STAGE(PG8_SA(0, 1), a2 + hstep, voffA);
            PG8_WAIT_L(8); PG8_BAR; PG8_WAIT_L(0); PG8_MMA(0, 0, At, B0); PG8_BAR; PG8_SCHED;
            PG8_LDB(B1, 1, 1); PG8_STAGE(PG8_SB(1, 0), b3, voffB);
            PG8_BAR; PG8_WAIT_L(0); PG8_MMA(0, 1, At, B1); PG8_BAR;
            PG8_LDA(At, 1, 1); PG8_STAGE(PG8_SA(1, 0), a3, voffA);
            PG8_BAR; PG8_WAIT_L(0); PG8_MMA(1, 0, At, B0); PG8_BAR; PG8_SCHED;
            PG8_STAGE(PG8_SB(1, 1), b3 + hstep, voffB);
            PG8_WAIT_V(6); PG8_BAR; PG8_MMA(1, 1, At, B1); PG8_BAR;
            }
        }
        if constexpr (ALIGN_EPI) { if (wr == 0) PG8_BAR; }
        if constexpr (!Epi::AFTER_DRAIN) { E(acc, cur, wr, wc, fr, fq); S.done(cur); }
        if (!has_next) break;
#pragma unroll
        for (int a = 0; a < 2; ++a)
#pragma unroll
            for (int b = 0; b < 2; ++b)
#pragma unroll
                for (int m = 0; m < 4; ++m)
#pragma unroll
                    for (int n = 0; n < 2; ++n) acc[a][b][m][n] = (f32x4){0.f, 0.f, 0.f, 0.f};
        cur = nxt; cA = nA; cB = nB; ++ui;
        if constexpr (GATHER) { cv0[0] = nv0[0]; cv0[1] = nv0[1]; cv1[0] = nv1[0]; cv1[1] = nv1[1]; }
        if constexpr (ALIGN_EPI) { if (wr == 1) PG8_BAR; }
    }
    PG8_WAIT_V(0);
    if constexpr (!ALIGN_EPI) { if (wr == 0) PG8_BAR; }
    PG8_BAR;
    if constexpr (Epi::AFTER_DRAIN) { E.fused(acc, cur, wr, wc, fr, fq, lds, wid, lane); S.done(cur); }
#undef PG8_SA
#undef PG8_GVOFF
#undef PG8_C0
#undef PG8_C1
#undef PG8_W0
#undef PG8_W1
#undef PG8_SB
#undef PG8_STAGE
#undef PG8_LDA
#undef PG8_LDB
#undef PG8_MMA
#undef PG8_WAIT_V
#undef PG8_WAIT_L
#undef PG8_BAR
#undef PG8_SCHED
}
}
#define XB_TMO      128
#define XB_XCNT(j)  (256  + 64 * (j))
#define XB_XSUB(j)  (1280 + 64 * (j))
#define XB_XGEN(j)  (2304 + 64 * (j))
#define XB_TOP      3328
#define XB_TOPGEN   3392
#define XCD_BAR_WORDS 3456
#define XB_SPIN_CAP (1u << 18)
#define LAS __attribute__((address_space(3)))

__device__ __forceinline__ unsigned xb_ld(unsigned* p)              { return __hip_atomic_load(p, __ATOMIC_RELAXED, __HIP_MEMORY_SCOPE_AGENT); }
__device__ __forceinline__ unsigned xb_add(unsigned* p, unsigned v) { return __hip_atomic_fetch_add(p, v, __ATOMIC_RELAXED, __HIP_MEMORY_SCOPE_AGENT); }
__device__ __forceinline__ unsigned xb_xcc_id() { return (unsigned)__builtin_amdgcn_s_getreg((3 << 11) | 20) & 0xFu; }
#define XB_SPIN(cond, bar) do { unsigned _sp = 0; while (cond) { __builtin_amdgcn_s_sleep(1); \
    if ((++_sp & 255u) == 0u) { if (xb_ld(&(bar)[XB_TMO])) break; if (_sp > XB_SPIN_CAP) { atomicAdd(&(bar)[XB_TMO], 1u); break; } } } } while (0)

struct XcdBarrier {
    unsigned* bar; unsigned x;
    volatile LAS unsigned* st;
};

__device__ __forceinline__ XcdBarrier xcd_barrier_post(unsigned* bar, volatile LAS unsigned* st) {
    XcdBarrier b; b.bar = bar; b.x = xb_xcc_id(); b.st = st;
    if (threadIdx.x == 0) (void)xb_add(&bar[XB_XCNT(b.x)], 1u);
    return b;
}
__device__ __forceinline__ void xcd_barrier_complete(unsigned* bar, unsigned x, unsigned& nloc, unsigned& nx) {
    const unsigned G = gridDim.x * gridDim.y * gridDim.z;
    unsigned sum, cnt, mine, sp = 0u;
    for (;;) {
        sum = 0u; cnt = 0u; mine = 0u;
#pragma unroll
        for (unsigned j = 0; j < 16; ++j) { const unsigned c = xb_ld(&bar[XB_XCNT(j)]); sum += c; cnt += (c > 0u) ? 1u : 0u; mine = (j == x) ? c : mine; }
        if (sum == G) break;
        __builtin_amdgcn_s_sleep(1);
        if ((++sp & 255u) == 0u) { if (xb_ld(&bar[XB_TMO])) break; if (sp > XB_SPIN_CAP) { atomicAdd(&bar[XB_TMO], 1u); break; } }
    }
    nloc = mine > 0u ? mine : 1u; nx = cnt > 0u ? cnt : 1u;
}

__device__ __forceinline__ void xcd_barrier(const XcdBarrier& b) {
    asm volatile("s_waitcnt vmcnt(0)" ::: "memory");
    __syncthreads();
    if (threadIdx.x == 0) {
        unsigned* bar = b.bar;
        __builtin_amdgcn_s_waitcnt(0);
        unsigned nloc = b.st[0], nx = b.st[1];
        if (nloc == 0u) { xcd_barrier_complete(bar, b.x, nloc, nx); b.st[0] = nloc; b.st[1] = nx; }
        const unsigned old = xb_add(&bar[XB_XSUB(b.x)], 1u);
        const unsigned gen = old / nloc;
        if (old + 1u == (gen + 1u) * nloc) {
            __builtin_amdgcn_fence(__ATOMIC_RELEASE, "agent");
            asm volatile("s_waitcnt vmcnt(0)" ::: "memory");
            const unsigned og = xb_add(&bar[XB_TOP], 1u);
            const unsigned tg = og / nx;
            if (og + 1u == (tg + 1u) * nx) xb_add(&bar[XB_TOPGEN], 1u);
            else XB_SPIN(xb_ld(&bar[XB_TOPGEN]) == tg, bar);
            __builtin_amdgcn_fence(__ATOMIC_ACQUIRE, "agent");
            xb_add(&bar[XB_XGEN(b.x)], 1u);
            asm volatile("s_waitcnt vmcnt(0)" ::: "memory");
        } else {
            XB_SPIN(xb_ld(&bar[XB_XGEN(b.x)]) == gen, bar);
            __builtin_amdgcn_fence(__ATOMIC_ACQUIRE, "agent");
            asm volatile("s_waitcnt vmcnt(0)" ::: "memory");
        }
    }
    __syncthreads();
}
namespace mk {
using pg8::bf16_t; using pg8::bf16x8; using pg8::f32x4; using pg8::u32x4;
typedef short s16x4 __attribute__((ext_vector_type(4)));
typedef float f32x16 __attribute__((ext_vector_type(16)));
typedef unsigned u32x2 __attribute__((ext_vector_type(2)));

constexpr int DM = 2048, NB = 4, SEQ = 4096, T = NB * SEQ;
constexpr int LDP = 6912;
constexpr int COL_Q = 0, COL_KC = 1024, COL_VC = 1280, COL_KS = 1536, COL_VS = 1792, COL_KW = 2048, COL_VW = 2304,
              COL_HQ = 2560, COL_HF = 3584, COL_HI = 4608, COL_HG = 5632, COL_GATE = 6656;
constexpr float EPS = 1e-6f;
constexpr int NTHR = 512;
constexpr int LDS_BYTES = 159744;
constexpr int MISC_OFF = 155648;

constexpr size_t al256(size_t x) { return (x + 255) & ~(size_t)255; }
constexpr size_t WS_CTL = 0, CTL_BYTES = 32768;
constexpr size_t CTL_CNT = 16384;
constexpr size_t WS_MOD = WS_CTL + CTL_BYTES;
constexpr size_t WS_COS = WS_MOD + 4 * 12288 * 4;
constexpr size_t WS_SIN = WS_COS + (size_t)T * 64 * 4;
constexpr size_t WS_WR = WS_SIN + (size_t)T * 64 * 4;
constexpr size_t WS_BR = WS_WR + 4 * 2048 * 48 * 4;
constexpr size_t WS_LB = WS_BR + 1024;
constexpr size_t WS_PEB = WS_LB + 4096;
constexpr size_t WS_CW1 = WS_PEB + 1024;
constexpr size_t WS_CW2 = WS_CW1 + 2 * 128 * 4096 * 2;
constexpr size_t WS_KC = WS_CW2 + 2 * 128 * 128 * 2;
constexpr size_t WS_VC = WS_KC + 8 * 256 * 128 * 2;
constexpr size_t WS_DECAY = WS_VC + 8 * 256 * 128 * 2;
constexpr size_t WS_EBM = WS_DECAY + 2048 * 128 * 4;
constexpr size_t WS_R2 = WS_EBM + 2048 * 128 * 4;
constexpr size_t WS_TOKE = WS_R2 + T * 4;
constexpr size_t WS_TOKW = WS_TOKE + T * 8;
constexpr size_t WS_TOKP = WS_TOKW + T * 8;
constexpr size_t WS_RTOK = WS_TOKP + T * 8;
constexpr size_t WS_RWE = WS_RTOK + 32 * 16384 * 4;
constexpr size_t WS_GWF = WS_RWE + 32 * 16384 * 4;
constexpr size_t WS_W1T = al256(WS_GWF + 64 * 2 * 64 * 8 * 2);
constexpr size_t WS_W2T = WS_W1T + (size_t)6912 * 2048 * 2;
constexpr size_t WS_PROJ = WS_W2T + (size_t)2048 * 2048 * 2;
constexpr size_t WS_HID = WS_PROJ, WS_YD = WS_PROJ + (size_t)48 * 1024 * 1024;
constexpr size_t WS_R3 = WS_PROJ + (size_t)T * LDP * 2;
constexpr size_t WS_R4 = WS_R3 + (size_t)T * 2048 * 2;
constexpr size_t WS_WGU = WS_R4 + (size_t)T * 2048 * 2;
constexpr size_t WS_WD = WS_WGU + (size_t)32 * 1024 * 2048 * 2;
constexpr size_t WS_END = WS_WD + (size_t)32 * 2048 * 512 * 2;

struct Params { const float* in[26]; float* out; unsigned char* ws; int ph_lo, ph_hi; };

__device__ __forceinline__ float bf2f(unsigned short h) { return __uint_as_float((unsigned)h << 16); }
__device__ __forceinline__ unsigned short f2bf(float f) { unsigned u = __float_as_uint(f); u += 0x7FFFu + ((u >> 16) & 1u); return (unsigned short)(u >> 16); }
__device__ __forceinline__ unsigned cvtpk(float lo, float hi) { unsigned r; asm volatile("v_cvt_pk_bf16_f32 %0, %1, %2" : "=v"(r) : "v"(lo), "v"(hi)); return r; }
__device__ __forceinline__ bf16x8 pack8(f32x4 a, f32x4 b) { u32x4 w = {cvtpk(a[0], a[1]), cvtpk(a[2], a[3]), cvtpk(b[0], b[1]), cvtpk(b[2], b[3])}; return *reinterpret_cast<bf16x8*>(&w); }
__device__ __forceinline__ float sigmoidf_(float x) { return 1.0f / (1.0f + __expf(-x)); }
__device__ __forceinline__ float wave_sum(float v) {
#pragma unroll
    for (int o = 32; o >= 1; o >>= 1) v += __shfl_xor(v, o);
    return v;
}

struct XT { const float* src; int ld; int valid; bf16_t* dst; int dld; int perm; };
__host__ __device__ __forceinline__ int ropedim(int j) { return ((j >> 3) << 2) + (j & 3) + (((j >> 2) & 1) << 6); }
constexpr int XT_WIN = 52 * 16, XT_WOUT = 16 * 16, XT_MOE = 32 * 4 * 16, XT_CW1 = 32, XT_CW2 = 1;
constexpr int XT_TOTAL = XT_WIN + XT_WOUT + 3 * XT_MOE + 2 * XT_CW1 + 2 * XT_CW2;
__device__ __forceinline__ XT xt_decode(const Params& p, int t) {
    XT x; unsigned char* ws = p.ws;
    if (t < XT_WIN) { const int nt = t / 16, kt = t % 16, n0 = nt * 128, k0 = kt * 128;
        const int on = n0 < 2560 ? n0 : n0 + 24;
        x.valid = 128;
        x.src = p.in[9] + (size_t)k0 * 6680 + on; x.ld = 6680; x.dst = (bf16_t*)(ws + WS_W1T) + (size_t)n0 * 2048 + k0; x.dld = 2048;
        x.perm = (n0 < 1280 || (n0 >= 1536 && n0 < 1792) || (n0 >= 2048 && n0 < 2304)) ? 1 : 0; return x; }
    t -= XT_WIN;
    if (t < XT_WOUT) { const int nt = t / 16, kt = t % 16, n0 = nt * 128, k0 = kt * 128;
        x.valid = 128; x.src = p.in[10] + (size_t)k0 * 2048 + n0; x.ld = 2048; x.dst = (bf16_t*)(ws + WS_W2T) + (size_t)n0 * 2048 + k0; x.dld = 2048; x.perm = 0; return x; }
    t -= XT_WOUT;
    if (t < 2 * XT_MOE) { const int up = t >= XT_MOE; if (up) t -= XT_MOE; const int e = t / 64, r = t % 64, nt = r / 16, kt = r % 16, n0 = nt * 128, k0 = kt * 128;
        x.valid = 128; x.src = p.in[up ? 24 : 23] + (size_t)e * 2048 * 512 + (size_t)k0 * 512 + n0; x.ld = 512;
        const int drow = e * 1024 + nt * 256 + (up ? 128 : 0);
        x.dst = (bf16_t*)(ws + WS_WGU) + (size_t)drow * 2048 + k0; x.dld = 2048; x.perm = 0; return x; }
    t -= 2 * XT_MOE;
    if (t < XT_MOE) { const int e = t / 64, r = t % 64, nt = r / 4, kt = r % 4, n0 = nt * 128, k0 = kt * 128;
        x.valid = 128; x.src = p.in[25] + (size_t)e * 512 * 2048 + (size_t)k0 * 2048 + n0; x.ld = 2048;
        x.dst = (bf16_t*)(ws + WS_WD) + (size_t)(e * 2048 + n0) * 512 + k0; x.dld = 512; x.perm = 0; return x; }
    t -= XT_MOE;
    if (t < 2 * XT_CW1) { const int kind = t / XT_CW1, kt = t % XT_CW1, k0 = kt * 128;
        x.valid = 128; x.src = p.in[kind ? 15 : 12] + (size_t)k0 * 128; x.ld = 128;
        x.dst = (bf16_t*)(ws + WS_CW1) + (size_t)kind * 128 * 4096 + k0; x.dld = 4096; x.perm = kind ? 0 : 2; return x; }
    t -= 2 * XT_CW1;
    { const int kind = t;
        x.valid = 128; x.src = p.in[kind ? 16 : 13]; x.ld = 128;
        x.dst = (bf16_t*)(ws + WS_CW2) + (size_t)kind * 128 * 128; x.dld = 128; x.perm = kind ? 0 : 1; return x; }
}
constexpr int XT_GU0 = XT_WIN + XT_WOUT, XT_DN0 = XT_GU0 + 2 * XT_MOE, XT_CW0 = XT_DN0 + XT_MOE;
constexpr int XT_GU_TAIL1 = 1280;
__device__ __forceinline__ void xpose_tiles(const Params& p, unsigned char* lds, int t_begin, int t_end, int worker, int nworkers) {
    const int tid = threadIdx.x;
    float* tile = (float*)lds;
    const int c4 = (tid & 31) * 4, k4 = tid >> 5;
    f32x4 a[8]; XT x{};
#define XT_LOAD(t_) do { if ((t_) < t_end) { x = xt_decode(p, (t_)); const float* s_ = x.src + (size_t)k4 * x.ld + c4; const bool ok_ = c4 < x.valid; \
        _Pragma("unroll") for (int i = 0; i < 8; ++i) a[i] = ok_ ? *(const f32x4*)(s_ + (size_t)(16 * i) * x.ld) : (f32x4){0.f, 0.f, 0.f, 0.f}; } } while (0)
    __syncthreads();
    XT_LOAD(t_begin + worker);
    for (int t = t_begin + worker; t < t_end; t += nworkers) {
#pragma unroll
        for (int i = 0; i < 8; ++i) { float* tp = tile + (k4 + 16 * i) * 129 + c4; tp[0] = a[i][0]; tp[1] = a[i][1]; tp[2] = a[i][2]; tp[3] = a[i][3]; }
        bf16_t* dst = x.dst; const int dld = x.dld, perm = x.perm;
        XT_LOAD(t + nworkers);
        __syncthreads();
        { const int nn = tid >> 2, kq = (tid & 3) * 8;
          const int sn = perm == 1 ? ropedim(nn) : nn;
#pragma unroll
          for (int j = 0; j < 4; ++j) { const int kb_ = kq + j * 32; float v[8];
              if (perm == 2) {
#pragma unroll
                  for (int e = 0; e < 8; ++e) v[e] = tile[ropedim(kb_ + e) * 129 + sn];
              } else { const float* tp = tile + kb_ * 129 + sn;
#pragma unroll
                  for (int e = 0; e < 8; ++e) v[e] = tp[e * 129]; }
              u32x4 w; w.x = cvtpk(v[0], v[1]); w.y = cvtpk(v[2], v[3]); w.z = cvtpk(v[4], v[5]); w.w = cvtpk(v[6], v[7]);
              *(u32x4*)(dst + (size_t)nn * dld + kb_) = w; } }
        __syncthreads();
    }
#undef XT_LOAD
}
__device__ __forceinline__ void p0_prologue(const Params& p, unsigned char* lds) {
    const int tid = threadIdx.x, G = gridDim.x, bx = blockIdx.x;
    unsigned char* ws = p.ws;
#ifndef MK_P0DUP
#define MK_P0DUP 0
#endif
    for (int rp_ = 0; rp_ < ((MK_P0DUP & 1) ? 2 : 1); ++rp_) if (bx < 192) {
        float* sc = (float*)lds; float* red = (float*)(lds + 32768);
        const float* c = p.in[1];
        for (int i = tid; i < 4 * 2048; i += NTHR) { const float v = c[i]; sc[i] = v / (1.0f + __expf(-v)); }
        __syncthreads();
        const int cg = tid & 15, ks = tid >> 4, col = bx * 64 + cg * 4;
        const float* w = p.in[3] + col;
        f32x4 acc[4] = {};
#pragma unroll 8
        for (int k = ks; k < 2048; k += 32) { const f32x4 wv = *(const f32x4*)(w + (size_t)k * 12288);
#pragma unroll
            for (int b = 0; b < 4; ++b) acc[b] += sc[b * 2048 + k] * wv; }
#pragma unroll
        for (int b = 0; b < 4; ++b) *(f32x4*)&red[(ks * 4 + b) * 64 + cg * 4] = acc[b];
        __syncthreads();
        if (tid < 256) { const int b = tid >> 6, cc = tid & 63; float s = 0.f;
            for (int k2 = 0; k2 < 32; ++k2) s += red[(k2 * 4 + b) * 64 + cc];
            ((float*)(ws + WS_MOD))[b * 12288 + bx * 64 + cc] = s + p.in[4][bx * 64 + cc]; }
        __syncthreads();
    }
    for (int rp_ = 0; rp_ < ((MK_P0DUP & 2) ? 2 : 1); ++rp_) {
        const int head = (G > 192) ? (G - 192) * 12 : 0;
        if (bx >= 192) xpose_tiles(p, lds, 0, head, bx - 192, G - 192);
        xpose_tiles(p, lds, head, XT_GU0, bx, G); xpose_tiles(p, lds, XT_GU0 + XT_GU_TAIL1, XT_DN0, bx, G); xpose_tiles(p, lds, XT_CW0, XT_TOTAL, bx, G); }
    { bf16_t* gwf = (bf16_t*)(ws + WS_GWF);
      for (int i = bx * NTHR + tid; i < 64 * 2 * 64 * 8; i += G * NTHR) { const int j = i & 7, ln = (i >> 3) & 63, cb = (i >> 9) & 1, s = i >> 10; const int n = 16 * cb + (ln & 15), k = 32 * s + 8 * (ln >> 4) + j;
          gwf[i] = n < 24 ? f2bf(p.in[9][(size_t)k * 6680 + 2560 + n]) : (bf16_t)0; } }
    for (int rp_ = 0; rp_ < ((MK_P0DUP & 4) ? 2 : 1); ++rp_) {
        const int* pos = (const int*)p.in[2]; float* ct = (float*)(ws + WS_COS); float* st = (float*)(ws + WS_SIN);
        const float inv = powf(10000.0f, -(float)(tid & 63) / 64.0f);
        for (int i = bx * NTHR + tid; i < T * 64; i += G * NTHR) { const int tok = i >> 6;
            const float ang = (float)pos[tok] * inv; float s, c; sincosf(ang, &s, &c); ct[i] = c; st[i] = s; }
    }
    if (bx == G - 1) { float* lb = (float*)(ws + WS_LB);
        for (int i = tid; i < 1024; i += NTHR) { const float a = p.in[17][i], b = p.in[17][1024 + i]; const float m = fmaxf(a, b); const float ea = expf(a - m), eb = expf(b - m); lb[i] = ea / (ea + eb); } }
    for (int rp_ = 0; rp_ < ((MK_P0DUP & 8) ? 2 : 1); ++rp_) for (int o = bx; o < 256; o += G) { const int kind = o >> 7, n = o & 127; const float* pe = p.in[kind ? 14 : 11]; const float* w1 = p.in[kind ? 15 : 12]; float* red = (float*)lds; float s = 0.f;
#pragma unroll
        for (int k = tid; k < 4096; k += NTHR) s += pe[k] * w1[(size_t)k * 128 + n];
        s = wave_sum(s); __syncthreads(); if ((tid & 63) == 0) red[tid >> 6] = s; __syncthreads();
        if (tid == 0) { float t = 0.f; for (int w = 0; w < 8; ++w) t += red[w]; ((float*)(ws + WS_PEB))[o] = t; } }
}

__device__ __forceinline__ void p1_norm1(const Params& p, unsigned char* lds) {
    const int tid = threadIdx.x, lane = tid & 63, wave = tid >> 6, G = gridDim.x, bx = blockIdx.x;
    unsigned char* ws = p.ws; const float* mod = (const float*)(ws + WS_MOD);
    const float* x = p.in[0]; const float* gpre = p.in[5]; bf16_t* h = (bf16_t*)(ws + WS_R3);
    float* pE = (float*)lds; float* pF = pE + 2048;
    for (int gi = bx; gi < T / 64; gi += G) {
        const int b = (gi * 64) >> 12; const float* md = mod + b * 12288;
        __syncthreads();
        for (int i = tid; i < 2048; i += NTHR) { pE[i] = gpre[i] * (1.0f + md[2048 + i]); pF[i] = md[i]; }
        __syncthreads();
        const int row0 = gi * 64 + wave * 8;
        f32x4 xa[8], xb[8];
#define P1_LOAD(X, j) do { const float* xr_ = x + (size_t)(row0 + (j)) * DM + lane * 4; _Pragma("unroll") for (int e = 0; e < 8; ++e) X[e] = *(const f32x4*)(xr_ + e * 256); } while (0)
#define P1_PROC(X, j) do { float ss = 0.f; _Pragma("unroll") for (int e = 0; e < 8; ++e) ss += X[e][0] * X[e][0] + X[e][1] * X[e][1] + X[e][2] * X[e][2] + X[e][3] * X[e][3]; \
        ss = wave_sum(ss); const float r = rsqrtf(ss * (1.0f / DM) + EPS); \
        _Pragma("unroll") for (int e = 0; e < 8; ++e) { const f32x4 ev = *(const f32x4*)(pE + e * 256 + lane * 4), fv = *(const f32x4*)(pF + e * 256 + lane * 4); const f32x4 o = X[e] * r * ev + fv; \
            u32x2 w; w.x = cvtpk(o[0], o[1]); w.y = cvtpk(o[2], o[3]); *(u32x2*)(h + (size_t)(row0 + (j)) * DM + e * 256 + lane * 4) = w; } } while (0)
        P1_LOAD(xa, 0);
        P1_LOAD(xb, 1); P1_PROC(xa, 0); P1_LOAD(xa, 2); P1_PROC(xb, 1); P1_LOAD(xb, 3); P1_PROC(xa, 2); P1_LOAD(xa, 4); P1_PROC(xb, 3);
        P1_LOAD(xb, 5); P1_PROC(xa, 4); P1_LOAD(xa, 6); P1_PROC(xb, 5); P1_LOAD(xb, 7); P1_PROC(xa, 6); P1_PROC(xb, 7);
#undef P1_LOAD
#undef P1_PROC
    }
    __syncthreads();
    float* WR = (float*)(ws + WS_WR); const float* gf = p.in[7]; const float* wg = p.in[19]; const float* wrt = p.in[21];
    for (int i = bx * NTHR + tid; i < 4 * 2048 * 48; i += G * NTHR) { const int n = i % 48, k = (i / 48) & 2047, b = i / (48 * 2048);
        const float a = gf[k] * (1.0f + mod[b * 12288 + 8192 + k]); const float w = n < 4 ? wg[k * 4 + n] : (n < 36 ? wrt[k * 32 + n - 4] : 0.f);
        const float val = a * w; const unsigned short vh = f2bf(val); const unsigned short vl = f2bf(val - bf2f(vh));
        const size_t idx = ((((size_t)b * 64 + (k >> 5)) * 3 + (n >> 4)) * 64 + ((k >> 3) & 3) * 16 + (n & 15)) * 8 + (k & 7);
        ((bf16_t*)WR)[idx] = vh; ((bf16_t*)WR)[393216 + idx] = vl; }
    if (bx < 4 * 48) { float* BR = (float*)(ws + WS_BR); float* red = (float*)lds;
        const int b = bx / 48, n = bx % 48; float s = 0.f;
        if (n < 36) for (int k = tid; k < 2048; k += NTHR) s += mod[b * 12288 + 6144 + k] * (n < 4 ? wg[k * 4 + n] : wrt[k * 32 + n - 4]);
        s = wave_sum(s); if (lane == 0) red[wave] = s; __syncthreads();
        if (tid == 0) { float t = 0.f; for (int w = 0; w < 8; ++w) t += red[w]; BR[bx] = n < 4 ? t + p.in[20][n] : (n < 36 ? t + p.in[22][n - 4] : 0.f); } }
}
constexpr float SCALE = 0.08838834764831845f;
constexpr float THR = 8.f;
constexpr int SHM_K = 16384, SHM_V = 16384;
#ifdef MK_SWZ15
#define KSWZ(row, colB) ((row) * 256 + ((colB) ^ (((row) & 15) << 4)))
#else
#define KSWZ(row, colB) ((row) * 256 + ((colB) ^ (((row) & 7) << 4)))
#endif
#define SBAR() __builtin_amdgcn_sched_barrier(0)
__device__ __forceinline__ int v_st(int k, int c) { const int kk = (k & ~0xC) | ((k & 4) << 1) | ((k & 8) >> 1); return ((kk >> 3) * 4 + (c >> 5)) * 512 + ((kk & 7) * 32 + (c & 31)) * 2; }
__device__ __forceinline__ int v_rd_base(int lane) { return ((lane & 3) << 3) | (((lane >> 2) & 3) << 6) | (((lane >> 4) & 1) << 5) | (((lane >> 5) & 1) << 8); }
constexpr int v_rd_off(int d0, int ks, int half) { return d0 * 512 + ks * 4096 + half * 2048; }
__device__ __forceinline__ int crow(int r, int hi) { return (r & 3) + 8 * (r >> 2) + 4 * hi; }
__device__ __forceinline__ void mask_tile(f32x16& p0, f32x16& p1, int dq, unsigned W) {
    const float NEG = -__builtin_inff();
#pragma unroll
    for (int r = 0; r < 16; ++r) {
        const int c = (r & 3) + 8 * (r >> 2);
        if ((unsigned)(dq - c) >= W) p0[r] = NEG;
        if ((unsigned)(dq - c - 32) >= W) p1[r] = NEG;
    }
}
__device__ __forceinline__ void partialSM(f32x16& p0, f32x16& p1, float& m_reg, float& mn, float& alpha) {
    float pmax;
    { float m8[8];
#pragma unroll
      for (int r = 0; r < 8; ++r) m8[r] = fmaxf(fmaxf(p0[r], p0[r + 8]), fmaxf(p1[r], p1[r + 8]));
      pmax = fmaxf(fmaxf(fmaxf(m8[0], m8[1]), fmaxf(m8[2], m8[3])), fmaxf(fmaxf(m8[4], m8[5]), fmaxf(m8[6], m8[7]))); }
    { auto rr = __builtin_amdgcn_permlane32_swap(__float_as_uint(pmax), __float_as_uint(pmax), false, false);
      pmax = fmaxf(__uint_as_float(rr[0]), __uint_as_float(rr[1])); }
    constexpr float C2 = 1.4426950408889634f * SCALE;
    if (__builtin_expect(__all((pmax - m_reg) * SCALE <= THR), 1)) { mn = m_reg; alpha = 1.f; }
    else { mn = fmaxf(m_reg, pmax); alpha = __builtin_amdgcn_exp2f((m_reg - mn) * C2); m_reg = mn; }
    const float mnL = -mn * C2;
    for (int r = 0; r < 16; ++r) p0[r] = fmaf(p0[r], C2, mnL); for (int r = 0; r < 16; ++r) p1[r] = fmaf(p1[r], C2, mnL);
    for (int r = 0; r < 16; ++r) p0[r] = __builtin_amdgcn_exp2f(p0[r]);
}
__device__ __forceinline__ void finishSM(f32x16& p0, f32x16& p1, float alpha, float& l_reg, bf16x8& pa0, bf16x8& pa1, bf16x8& pa2, bf16x8& pa3) {
    for (int r = 0; r < 16; ++r) p1[r] = __builtin_amdgcn_exp2f(p1[r]);
    float ps;
    { float s8[8];
#pragma unroll
      for (int r = 0; r < 8; ++r) s8[r] = (p0[r] + p0[r + 8]) + (p1[r] + p1[r + 8]);
      ps = ((s8[0] + s8[1]) + (s8[2] + s8[3])) + ((s8[4] + s8[5]) + (s8[6] + s8[7])); }
    { auto rr = __builtin_amdgcn_permlane32_swap(__float_as_uint(ps), __float_as_uint(ps), false, false);
      ps = __uint_as_float(rr[0]) + __uint_as_float(rr[1]); }
    l_reg = l_reg * alpha + ps;
#define PK4(P, B_, OUT) do { unsigned a0 = cvtpk(P[B_+0], P[B_+1]), a1 = cvtpk(P[B_+2], P[B_+3]);                          \
        unsigned b0 = cvtpk(P[B_+4], P[B_+5]), b1 = cvtpk(P[B_+6], P[B_+7]);                                             \
        auto r0 = __builtin_amdgcn_permlane32_swap(a0, b0, false, false); auto r1 = __builtin_amdgcn_permlane32_swap(a1, b1, false, false); \
        u32x4 w = {r0[0], r1[0], r0[1], r1[1]}; OUT = *reinterpret_cast<bf16x8*>(&w); } while (0)
    PK4(p0, 0, pa0); PK4(p0, 8, pa1); PK4(p1, 0, pa2); PK4(p1, 8, pa3);
#undef PK4
}
template <int KB, bool SK>
__device__ __forceinline__ void qkt(f32x16& p0, f32x16& p1, const char* K_lds, int r32, int hi, const bf16x8* qr, bool act) {
    if (SK && !act) { const float NEG = -__builtin_inff();
#pragma unroll
        for (int r = 0; r < 16; ++r) { p0[r] = NEG; p1[r] = NEG; } return; }
    p0 = f32x16{}; p1 = f32x16{};
    const unsigned kbase = (unsigned)(uintptr_t)K_lds + KB * SHM_K;
    unsigned kb[4];
#pragma unroll
    for (int dd = 0; dd < 4; ++dd) kb[dd] = kbase + KSWZ(r32, (dd * 16 + hi * 8) * 2);
#pragma unroll
    for (int d0 = 0; d0 < 8; ++d0) {
#ifdef MK_SWZ15
        const unsigned a = (d0 < 4) ? kb[d0 & 3] : (kb[d0 & 3] ^ 128u);
#else
        const unsigned a = kb[d0 & 3] + (d0 >> 2) * 128;
#endif
        bf16x8 b0 = *reinterpret_cast<const LAS bf16x8*>((uintptr_t)a);
        bf16x8 b1 = *reinterpret_cast<const LAS bf16x8*>((uintptr_t)(a + 32 * 256));
        p0 = __builtin_amdgcn_mfma_f32_32x32x16_bf16(b0, qr[d0], p0, 0, 0, 0);
        p1 = __builtin_amdgcn_mfma_f32_32x32x16_bf16(b1, qr[d0], p1, 0, 0, 0); }
}
template <int VB, bool SK>
__device__ __forceinline__ void pv_tile(f32x16* o, int vb0, bf16x8 pa0, bf16x8 pa1, bf16x8 pa2, bf16x8 pa3, bool act) {
    if (SK && !act) return;
#define TRRD(dst, off) asm volatile("ds_read_b64_tr_b16 %0, %1 offset:%2" : "=&v"(dst) : "v"(vb0), "i"(off) : "memory")
#define PV_D0(d0) do { s16x4 l0, l1, l2, l3, h0, h1, h2, h3; constexpr int b_ = VB * SHM_V + v_rd_off(d0, 0, 0);     \
        TRRD(l0, b_); TRRD(h0, b_ + 2048); TRRD(l1, b_ + 4096); TRRD(h1, b_ + 6144); TRRD(l2, b_ + 8192); TRRD(h2, b_ + 10240); TRRD(l3, b_ + 12288); TRRD(h3, b_ + 14336); \
        asm volatile("s_waitcnt lgkmcnt(0)" ::: "memory"); SBAR();                 \
        o[d0] = __builtin_amdgcn_mfma_f32_32x32x16_bf16(pa0, (bf16x8){l0[0], l0[1], l0[2], l0[3], h0[0], h0[1], h0[2], h0[3]}, o[d0], 0, 0, 0);   \
        o[d0] = __builtin_amdgcn_mfma_f32_32x32x16_bf16(pa1, (bf16x8){l1[0], l1[1], l1[2], l1[3], h1[0], h1[1], h1[2], h1[3]}, o[d0], 0, 0, 0);   \
        o[d0] = __builtin_amdgcn_mfma_f32_32x32x16_bf16(pa2, (bf16x8){l2[0], l2[1], l2[2], l2[3], h2[0], h2[1], h2[2], h2[3]}, o[d0], 0, 0, 0);   \
        o[d0] = __builtin_amdgcn_mfma_f32_32x32x16_bf16(pa3, (bf16x8){l3[0], l3[1], l3[2], l3[3], h3[0], h3[1], h3[2], h3[3]}, o[d0], 0, 0, 0); } while (0)
    PV_D0(0); PV_D0(1); PV_D0(2); PV_D0(3);
#undef PV_D0
#undef TRRD
}
__device__ __forceinline__ void qkt_rt(f32x16& p0, f32x16& p1, unsigned kbase, int r32, int hi, const bf16x8* qr) {
    p0 = f32x16{}; p1 = f32x16{};
    unsigned kb[4];
#pragma unroll
    for (int dd = 0; dd < 4; ++dd) kb[dd] = kbase + KSWZ(r32, (dd * 16 + hi * 8) * 2);
#ifdef MK_SWZ15
#define QK_ADDR(d0) (((d0) < 4) ? kb[(d0) & 3] : (kb[(d0) & 3] ^ 128u))
#else
#define QK_ADDR(d0) (kb[(d0) & 3] + ((d0) >> 2) * 128)
#endif
#define QK_RD(d0, x0, x1) do { const unsigned a_ = QK_ADDR(d0); asm volatile("ds_read_b128 %0, %1" : "=v"(x0) : "v"(a_) : "memory"); asm volatile("ds_read_b128 %0, %1 offset:8192" : "=v"(x1) : "v"(a_) : "memory"); } while (0)
#define QK_MM(d0, x0, x1, N) do { asm volatile("s_waitcnt lgkmcnt(" #N ")" ::: "memory"); SBAR(); \
        p0 = __builtin_amdgcn_mfma_f32_32x32x16_bf16(x0, qr[d0], p0, 0, 0, 0); p1 = __builtin_amdgcn_mfma_f32_32x32x16_bf16(x1, qr[d0], p1, 0, 0, 0); SBAR(); } while (0)
    bf16x8 a0, a1, b0, b1, c0, c1;
    QK_RD(0, a0, a1); QK_RD(1, b0, b1);
    QK_RD(2, c0, c1); QK_MM(0, a0, a1, 4);
    QK_RD(3, a0, a1); QK_MM(1, b0, b1, 4);
    QK_RD(4, b0, b1); QK_MM(2, c0, c1, 4);
    QK_RD(5, c0, c1); QK_MM(3, a0, a1, 4);
    QK_RD(6, a0, a1); QK_MM(4, b0, b1, 4);
    QK_RD(7, b0, b1); QK_MM(5, c0, c1, 4);
    QK_MM(6, a0, a1, 2);
    QK_MM(7, b0, b1, 0);
#undef QK_MM
#undef QK_RD
#undef QK_ADDR
}
#define TRRD2(lo, hi_, base, off) do { asm volatile("ds_read_b64_tr_b16 %0, %1 offset:%2" : "=&v"(lo) : "v"(base), "i"(off) : "memory"); \
                                        asm volatile("ds_read_b64_tr_b16 %0, %1 offset:%2" : "=&v"(hi_) : "v"(base), "i"((off) + 2048) : "memory"); } while (0)
#define MK8(l, h) ((bf16x8){l[0], l[1], l[2], l[3], h[0], h[1], h[2], h[3]})
#define LGKM0() do { asm volatile("s_waitcnt lgkmcnt(0)" ::: "memory"); SBAR(); } while (0)
__device__ __forceinline__ int lds_addr(const void* p) { return (int)(uintptr_t)p; }

__device__ __forceinline__ void gates_pass(const Params& p, int worker, int nworkers) {
    const int tid = threadIdx.x, lane = tid & 63, wave = tid >> 6, fr = lane & 15, fq = lane >> 4;
    const bf16_t* h = (const bf16_t*)(p.ws + WS_R3); const bf16_t* gwf = (const bf16_t*)(p.ws + WS_GWF) + lane * 8; bf16_t* proj = (bf16_t*)(p.ws + WS_PROJ);
    for (int rb = worker * 8 + wave; rb < T / 16; rb += nworkers * 8) {
        const bf16_t* hr = h + (size_t)(rb * 16 + fr) * DM + fq * 8; f32x4 a0 = {}, a1 = {};
#pragma unroll 8
        for (int s = 0; s < 64; ++s) { const bf16x8 A = *(const bf16x8*)(hr + s * 32), B0 = *(const bf16x8*)(gwf + s * 1024), B1 = *(const bf16x8*)(gwf + s * 1024 + 512);
            a0 = __builtin_amdgcn_mfma_f32_16x16x32_bf16(A, B0, a0, 0, 0, 0); a1 = __builtin_amdgcn_mfma_f32_16x16x32_bf16(A, B1, a1, 0, 0, 0); }
#pragma unroll
        for (int r = 0; r < 4; ++r) { bf16_t* o = proj + (size_t)(rb * 16 + fq * 4 + r) * LDP + COL_GATE; o[fr] = f2bf(a0[r]); if (fr < 8) o[16 + fr] = f2bf(a1[r]); }
    }
}
__device__ __forceinline__ void rope_pass(const Params& p, bool dry) {
    bf16_t* proj = (bf16_t*)(p.ws + WS_PROJ); const float* ct = (const float*)(p.ws + WS_COS); const float* st = (const float*)(p.ws + WS_SIN);
    for (int i = blockIdx.x * NTHR + threadIdx.x; i < T * 4 * 8; i += gridDim.x * NTHR) {
        const int ch = i & 7, hd = (i >> 3) & 3, tok = i >> 5;
        const int col = hd < 2 ? COL_KS + hd * 128 : COL_KW + (hd - 2) * 128;
        bf16_t* a = proj + (size_t)tok * LDP + col + ch * 8;
        const bf16x8 t1 = *(const bf16x8*)a, t2 = *(const bf16x8*)(a + 64);
        const f32x4 c0 = *(const f32x4*)(ct + tok * 64 + ch * 8), c1 = *(const f32x4*)(ct + tok * 64 + ch * 8 + 4);
        const f32x4 s0 = *(const f32x4*)(st + tok * 64 + ch * 8), s1 = *(const f32x4*)(st + tok * 64 + ch * 8 + 4);
        float o1[8], o2[8];
#pragma unroll
        for (int j = 0; j < 8; ++j) { const float x1 = bf2f((unsigned short)t1[j]), x2 = bf2f((unsigned short)t2[j]); const float c = j < 4 ? c0[j & 3] : c1[j & 3], s = j < 4 ? s0[j & 3] : s1[j & 3];
            o1[j] = x1 * c - x2 * s; o2[j] = x2 * c + x1 * s; }
        u32x4 w1 = {cvtpk(o1[0], o1[1]), cvtpk(o1[2], o1[3]), cvtpk(o1[4], o1[5]), cvtpk(o1[6], o1[7])};
        u32x4 w2 = {cvtpk(o2[0], o2[1]), cvtpk(o2[2], o2[3]), cvtpk(o2[4], o2[5]), cvtpk(o2[6], o2[7])};
        if (!dry) { *(u32x4*)a = w1; *(u32x4*)(a + 64) = w2; } else if (w1.x == 0x7fc12345u) { *(unsigned*)(p.ws + WS_END) = w2.y; }
    }
}

__device__ __forceinline__ float fexp2(float x) { return __builtin_amdgcn_exp2f(x); }
__device__ __forceinline__ float flog2(float x) { return __builtin_amdgcn_logf(x); }
__device__ __forceinline__ float frcp(float x) { return __builtin_amdgcn_rcpf(x); }
__device__ __forceinline__ float fsigmoid(float x) { return frcp(1.0f + fexp2(-1.4426950408889634f * x)); }
__device__ __forceinline__ float bflo(unsigned w) { return __uint_as_float(w << 16); }
__device__ __forceinline__ float bfhi(unsigned w) { return __uint_as_float(w & 0xffff0000u); }
struct H1Regs { unsigned hfw[8], hqw[8]; bf16x8 v0, v1; };
__device__ __forceinline__ void h1_load(const Params& p, int u, H1Regs& R) {
    const int tid = threadIdx.x, lane = tid & 63, wave = tid >> 6; const int b = u >> 9, h = (u >> 6) & 7, c = u & 63, t0 = b * SEQ + c * 64;
    const bf16_t* proj = (const bf16_t*)(p.ws + WS_PROJ); const bf16_t* rowp = proj + (size_t)(t0 + wave * 8) * LDP + h * 128 + 2 * lane;
#pragma unroll
    for (int j = 0; j < 8; ++j) { R.hfw[j] = *(const unsigned*)(rowp + (size_t)j * LDP + COL_HF); R.hqw[j] = *(const unsigned*)(rowp + (size_t)j * LDP + COL_HQ); }
    const int sr = tid >> 4, sc = (tid & 15) * 8; const bf16_t* vp = proj + (size_t)(t0 + sr) * LDP + COL_HI + h * 128 + sc; R.v0 = *(const bf16x8*)vp; R.v1 = *(const bf16x8*)(vp + (size_t)32 * LDP);
}
__device__ __forceinline__ void hgrn_h1_phase(const Params& p, unsigned char* lds, bool dry) {
    const int tid = threadIdx.x, lane = tid & 63, wave = tid >> 6, r32 = lane & 31, hi = lane >> 5, G = gridDim.x;
    bf16_t* proj = (bf16_t*)(p.ws + WS_PROJ);
    unsigned char* KS = lds; unsigned char* VI = lds + 16384; float* qt = (float*)(lds + 32768);
    unsigned char* SLT = lds + 40960;
    int u = blockIdx.x; if (u >= 2048) return;
    H1Regs R; h1_load(p, u, R);
    for (; u < 2048; u += G) {
    const int b = u >> 9, h = (u >> 6) & 7, c = u & 63, t0 = b * SEQ + c * 64;
    const float* lbp = (const float*)(p.ws + WS_LB) + h * 128 + 2 * lane; const float lb0 = lbp[0], lb1 = lbp[1];
    bf16_t* rowp = proj + (size_t)(t0 + wave * 8) * LDP + h * 128 + 2 * lane;
    float bc0[8], bc1[8], k0[8], k1[8], qs0[8], qs1[8]; float run0 = 0.f, run1 = 0.f;
#pragma unroll
    for (int j = 0; j < 8; ++j) { const float f0 = lb0 + (1.0f - lb0) * fsigmoid(bflo(R.hfw[j])), f1 = lb1 + (1.0f - lb1) * fsigmoid(bfhi(R.hfw[j]));
        run0 += flog2(f0); run1 += flog2(f1); bc0[j] = run0; bc1[j] = run1; k0[j] = 1.0f - f0; k1[j] = 1.0f - f1;
        const float q0 = bflo(R.hqw[j]), q1 = bfhi(R.hqw[j]); qs0[j] = q0 * fsigmoid(q0); qs1[j] = q1 * fsigmoid(q1); }
    *(float2*)(qt + wave * 128 + 2 * lane) = make_float2(run0, run1);
    { const int sr = tid >> 4, sc = (tid & 15) * 8; *(bf16x8*)(VI + v_st(sr, sc)) = R.v0; *(bf16x8*)(VI + v_st(32 + sr, sc)) = R.v1; }
    if (u + G < 2048) h1_load(p, u + G, R);
    __syncthreads();
    float pre0 = 0.f, pre1 = 0.f, mid0 = 0.f, mid1 = 0.f, tot0 = 0.f, tot1 = 0.f;
#pragma unroll
    for (int w = 0; w < 8; ++w) { const float2 q = *(const float2*)(qt + w * 128 + 2 * lane); if (w < wave) { pre0 += q.x; pre1 += q.y; } if (w < 4) { mid0 += q.x; mid1 += q.y; } tot0 += q.x; tot1 += q.y; }
#pragma unroll
    for (int j = 0; j < 8; ++j) { const float c0 = bc0[j] + pre0, c1 = bc1[j] + pre1; const int key = wave * 8 + j;
        *(unsigned*)(KS + v_st(key, 2 * lane)) = cvtpk(k0[j] * fexp2(tot0 - c0), k1[j] * fexp2(tot1 - c1));
        const unsigned wk_ = cvtpk(k0[j] * fexp2(mid0 - c0), k1[j] * fexp2(mid1 - c1)), wq_ = cvtpk(qs0[j] * fexp2(c0 - mid0), qs1[j] * fexp2(c1 - mid1));
        if (!dry) { *(unsigned*)(rowp + (size_t)j * LDP + COL_HF) = wk_; *(unsigned*)(rowp + (size_t)j * LDP + COL_HQ) = wq_; } else if (wk_ == 0x7fc12345u) { *(unsigned*)(p.ws + WS_END) = wq_; } }
    if (wave == 0) { *(float2*)((float*)(p.ws + WS_DECAY) + u * 128 + 2 * lane) = make_float2(fexp2(tot0), fexp2(tot1));
                     *(float2*)((float*)(p.ws + WS_EBM) + u * 128 + 2 * lane) = make_float2(fexp2(mid0), fexp2(mid1)); }
    __syncthreads();
    const int db = wave >> 1; const int ka = lds_addr(KS) + v_rd_base(lane) + db * 512;
    bf16_t* Sl = (bf16_t*)(p.ws + WS_R3) + (size_t)u * 16384;
    s16x4 al[4], ah[4]; TRRD2(al[0], ah[0], ka, 0); TRRD2(al[1], ah[1], ka, 4096); TRRD2(al[2], ah[2], ka, 8192); TRRD2(al[3], ah[3], ka, 12288);
#pragma unroll
    for (int e2 = 0; e2 < 2; ++e2) { const int eb = (wave & 1) * 2 + e2; const int va = lds_addr(VI) + v_rd_base(lane) + eb * 512;
        s16x4 bl[4], bh[4]; TRRD2(bl[0], bh[0], va, 0); TRRD2(bl[1], bh[1], va, 4096); TRRD2(bl[2], bh[2], va, 8192); TRRD2(bl[3], bh[3], va, 12288);
        LGKM0();
        f32x16 acc = {};
#pragma unroll
        for (int ks = 0; ks < 4; ++ks) acc = __builtin_amdgcn_mfma_f32_32x32x16_bf16(MK8(al[ks], ah[ks]), MK8(bl[ks], bh[ks]), acc, 0, 0, 0);
#pragma unroll
        for (int r = 0; r < 16; ++r) *(bf16_t*)(SLT + (db * 32 + crow(r, hi)) * 256 + (eb * 32 + r32) * 2) = f2bf(acc[r]); }
    __syncthreads();
#pragma unroll
    for (int k = 0; k < 4; ++k) *(u32x4*)((unsigned char*)Sl + (tid + 512 * k) * 16) = *(const u32x4*)(SLT + (tid + 512 * k) * 16);
    __syncthreads();
    }
}
__device__ __forceinline__ void hgrn_h2_scan(const Params& p, int worker, int nworkers) {
    const bf16_t* Sl = (const bf16_t*)(p.ws + WS_R3); bf16_t* St = (bf16_t*)(p.ws + WS_R4); const float* decay = (const float*)(p.ws + WS_DECAY); const float* ebm = (const float*)(p.ws + WS_EBM);
    for (int i = worker * NTHR + threadIdx.x; i < 32 * 4096; i += nworkers * NTHR) {
        const int bh = i >> 12, e4 = (i & 4095) * 4, d = e4 >> 7; float s0 = 0.f, s1 = 0.f, s2 = 0.f, s3 = 0.f;
#pragma unroll 8
        for (int c = 0; c < 64; ++c) { const size_t u = (size_t)bh * 64 + c;
            const u32x2 sl = *(const u32x2*)(Sl + u * 16384 + e4); const float dc = decay[u * 128 + d], em = ebm[u * 128 + d];
            u32x2 w; w.x = cvtpk(s0 * em, s1 * em); w.y = cvtpk(s2 * em, s3 * em); *(u32x2*)(St + u * 16384 + e4) = w;
            s0 = dc * s0 + __uint_as_float(sl.x << 16); s1 = dc * s1 + __uint_as_float(sl.x & 0xffff0000u); s2 = dc * s2 + __uint_as_float(sl.y << 16); s3 = dc * s3 + __uint_as_float(sl.y & 0xffff0000u); }
    }
}
#define PK4(P, B_, OUT) do { unsigned a0 = cvtpk(P[B_+0], P[B_+1]), a1 = cvtpk(P[B_+2], P[B_+3]);                          \
        unsigned b0 = cvtpk(P[B_+4], P[B_+5]), b1 = cvtpk(P[B_+6], P[B_+7]);                                             \
        auto r0 = __builtin_amdgcn_permlane32_swap(a0, b0, false, false); auto r1 = __builtin_amdgcn_permlane32_swap(a1, b1, false, false); \
        u32x4 w = {r0[0], r1[0], r0[1], r1[1]}; OUT = *reinterpret_cast<bf16x8*>(&w); } while (0)
struct H3Regs { bf16x8 q0, q1, k0, k1, v0, v1, s0, s1, s2, s3, g0, g1; };
__device__ __forceinline__ void h3_load(const Params& p, int u, H3Regs& R, int tid) {
    const int sr = tid >> 4, sc = (tid & 15) * 8; const int b = u >> 9, h = (u >> 6) & 7, c = u & 63, t0 = b * SEQ + c * 64;
    const bf16_t* rp = (const bf16_t*)(p.ws + WS_PROJ) + (size_t)(t0 + sr) * LDP + h * 128 + sc; const size_t o32 = (size_t)32 * LDP;
    R.q0 = *(const bf16x8*)(rp + COL_HQ); R.q1 = *(const bf16x8*)(rp + COL_HQ + o32); R.k0 = *(const bf16x8*)(rp + COL_HF); R.k1 = *(const bf16x8*)(rp + COL_HF + o32);
    R.v0 = *(const bf16x8*)(rp + COL_HI); R.v1 = *(const bf16x8*)(rp + COL_HI + o32); R.g0 = *(const bf16x8*)(rp + COL_HG); R.g1 = *(const bf16x8*)(rp + COL_HG + o32);
    const bf16_t* sp = (const bf16_t*)(p.ws + WS_R4) + (size_t)u * 16384 + sr * 128 + sc;
    R.s0 = *(const bf16x8*)sp; R.s1 = *(const bf16x8*)(sp + 32 * 128); R.s2 = *(const bf16x8*)(sp + 64 * 128); R.s3 = *(const bf16x8*)(sp + 96 * 128);
}
__device__ __forceinline__ void hgrn_h3_phase(const Params& p, unsigned char* lds) {
    int tid = threadIdx.x; asm volatile("" : "+v"(tid));
    const int lane = tid & 63, wave = tid >> 6, r32 = lane & 31, hi = lane >> 5, G = gridDim.x;
    unsigned char* QT = lds; unsigned char* KT = lds + 16384; unsigned char* VI = lds + 32768; unsigned char* STI = lds + 49152; unsigned char* HG = lds + 81920;
    float* part = (float*)(lds + 98304);
    const int sr = tid >> 4, sc = (tid & 15) * 8;
    int u = blockIdx.x; if (u >= 2048) return;
    H3Regs R; h3_load(p, u, R, tid);
    for (; u < 2048; u += G) {
        const int b = u >> 9, h = (u >> 6) & 7, c = u & 63, t0 = b * SEQ + c * 64;
        *(bf16x8*)(QT + KSWZ(sr, sc * 2)) = R.q0; *(bf16x8*)(QT + KSWZ(32 + sr, sc * 2)) = R.q1; *(bf16x8*)(KT + KSWZ(sr, sc * 2)) = R.k0; *(bf16x8*)(KT + KSWZ(32 + sr, sc * 2)) = R.k1;
        *(bf16x8*)(VI + v_st(sr, sc)) = R.v0; *(bf16x8*)(VI + v_st(32 + sr, sc)) = R.v1;
        *(bf16x8*)(STI + v_st(sr, sc)) = R.s0; *(bf16x8*)(STI + v_st(32 + sr, sc)) = R.s1; *(bf16x8*)(STI + 16384 + v_st(sr, sc)) = R.s2; *(bf16x8*)(STI + 16384 + v_st(32 + sr, sc)) = R.s3;
        *(bf16x8*)(HG + sr * 256 + sc * 2) = R.g0; *(bf16x8*)(HG + (32 + sr) * 256 + sc * 2) = R.g1;
        if (u + G < 2048) h3_load(p, u + G, R, tid);
        __syncthreads();
        const int ib = wave >> 2, eb = wave & 3, irow = ib * 32 + r32;
        bf16x8 qf8[8];
#pragma unroll
        for (int d0 = 0; d0 < 8; ++d0) qf8[d0] = *(const bf16x8*)(QT + KSWZ(irow, (d0 * 16 + hi * 8) * 2));
        f32x16 p0, p1; qkt_rt(p0, p1, (unsigned)lds_addr(KT), r32, hi, qf8);
#pragma unroll
        for (int r = 0; r < 16; ++r) { const int j = crow(r, hi); if (j > irow) p0[r] = 0.f; if (j + 32 > irow) p1[r] = 0.f; }
        bf16x8 pa0, pa1, pa2, pa3; PK4(p0, 0, pa0); PK4(p0, 8, pa1); PK4(p1, 0, pa2); PK4(p1, 8, pa3);
        f32x16 o = {};
        { const int va = lds_addr(VI) + v_rd_base(lane) + eb * 512; s16x4 l0, h0, l1, h1, l2, h2, l3, h3;
          TRRD2(l0, h0, va, 0); TRRD2(l1, h1, va, 4096); TRRD2(l2, h2, va, 8192); TRRD2(l3, h3, va, 12288); LGKM0();
          o = __builtin_amdgcn_mfma_f32_32x32x16_bf16(pa0, MK8(l0, h0), o, 0, 0, 0); o = __builtin_amdgcn_mfma_f32_32x32x16_bf16(pa1, MK8(l1, h1), o, 0, 0, 0);
          o = __builtin_amdgcn_mfma_f32_32x32x16_bf16(pa2, MK8(l2, h2), o, 0, 0, 0); o = __builtin_amdgcn_mfma_f32_32x32x16_bf16(pa3, MK8(l3, h3), o, 0, 0, 0); }
        { const int sa = lds_addr(STI) + v_rd_base(lane) + eb * 512; s16x4 l0, h0, l1, h1, l2, h2, l3, h3;
          TRRD2(l0, h0, sa, 0); TRRD2(l1, h1, sa, 4096); TRRD2(l2, h2, sa, 8192); TRRD2(l3, h3, sa, 12288); LGKM0();
          o = __builtin_amdgcn_mfma_f32_32x32x16_bf16(qf8[0], MK8(l0, h0), o, 0, 0, 0); o = __builtin_amdgcn_mfma_f32_32x32x16_bf16(qf8[1], MK8(l1, h1), o, 0, 0, 0);
          o = __builtin_amdgcn_mfma_f32_32x32x16_bf16(qf8[2], MK8(l2, h2), o, 0, 0, 0); o = __builtin_amdgcn_mfma_f32_32x32x16_bf16(qf8[3], MK8(l3, h3), o, 0, 0, 0);
          TRRD2(l0, h0, sa, 16384); TRRD2(l1, h1, sa, 16384 + 4096); TRRD2(l2, h2, sa, 16384 + 8192); TRRD2(l3, h3, sa, 16384 + 12288); LGKM0();
          o = __builtin_amdgcn_mfma_f32_32x32x16_bf16(qf8[4], MK8(l0, h0), o, 0, 0, 0); o = __builtin_amdgcn_mfma_f32_32x32x16_bf16(qf8[5], MK8(l1, h1), o, 0, 0, 0);
          o = __builtin_amdgcn_mfma_f32_32x32x16_bf16(qf8[6], MK8(l2, h2), o, 0, 0, 0); o = __builtin_amdgcn_mfma_f32_32x32x16_bf16(qf8[7], MK8(l3, h3), o, 0, 0, 0); }
        __syncthreads();
        { float* OT = (float*)lds;
#pragma unroll
          for (int r = 0; r < 16; ++r) OT[(ib * 32 + crow(r, hi)) * 128 + eb * 32 + r32] = o[r]; }
        __syncthreads();
        { const int row = tid >> 3, seg = tid & 7; const float* orow = (const float*)lds + row * 128 + seg * 16;
          const f32x4 v0 = *(const f32x4*)orow, v1 = *(const f32x4*)(orow + 4), v2 = *(const f32x4*)(orow + 8), v3 = *(const f32x4*)(orow + 12);
          float ss = (v0[0] * v0[0] + v0[1] * v0[1] + v0[2] * v0[2] + v0[3] * v0[3]) + (v1[0] * v1[0] + v1[1] * v1[1] + v1[2] * v1[2] + v1[3] * v1[3])
                   + (v2[0] * v2[0] + v2[1] * v2[1] + v2[2] * v2[2] + v2[3] * v2[3]) + (v3[0] * v3[0] + v3[1] * v3[1] + v3[2] * v3[2] + v3[3] * v3[3]);
          ss += __shfl_xor(ss, 1); ss += __shfl_xor(ss, 2); ss += __shfl_xor(ss, 4);
          const float rn = __builtin_amdgcn_rsqf(ss * (1.0f / 128.0f) + EPS);
          const float* gnp = p.in[18] + h * 128 + seg * 16; const f32x4 g0 = *(const f32x4*)gnp, g1 = *(const f32x4*)(gnp + 4), g2 = *(const f32x4*)(gnp + 8), g3 = *(const f32x4*)(gnp + 12);
          const bf16x8 ha = *(const bf16x8*)(HG + row * 256 + seg * 32), hb = *(const bf16x8*)(HG + row * 256 + seg * 32 + 16);
          float ov[16];
#pragma unroll
          for (int j = 0; j < 4; ++j) { const float ga = bf2f((unsigned short)ha[j]), gb = bf2f((unsigned short)ha[4 + j]), gc = bf2f((unsigned short)hb[j]), gd = bf2f((unsigned short)hb[4 + j]);
              ov[j] = v0[j] * rn * g0[j] * ga * fsigmoid(ga); ov[4 + j] = v1[j] * rn * g1[j] * gb * fsigmoid(gb); ov[8 + j] = v2[j] * rn * g2[j] * gc * fsigmoid(gc); ov[12 + j] = v3[j] * rn * g3[j] * gd * fsigmoid(gd); }
          bf16_t* oc = (bf16_t*)(p.ws + WS_R3) + (size_t)(t0 + row) * 2048 + 1024 + h * 128 + seg * 16;
          *(u32x4*)oc = (u32x4){cvtpk(ov[0], ov[1]), cvtpk(ov[2], ov[3]), cvtpk(ov[4], ov[5]), cvtpk(ov[6], ov[7])};
          *(u32x4*)(oc + 8) = (u32x4){cvtpk(ov[8], ov[9]), cvtpk(ov[10], ov[11]), cvtpk(ov[12], ov[13]), cvtpk(ov[14], ov[15])}; }
        __syncthreads();
    }
}

__device__ __forceinline__ void compress_unit(const Params& p, unsigned char* lds, int u) {
    const int tid = threadIdx.x, lane = tid & 63, wave = tid >> 6, fr = lane & 15, fq = lane >> 4;
    const int kind = u >> 6, b = (u >> 4) & 3, g = (u >> 3) & 1, ct = u & 7;
    const bf16_t* proj = (const bf16_t*)(p.ws + WS_PROJ) + (size_t)b * SEQ * LDP + (kind ? COL_VC : COL_KC) + g * 128;
    const bf16_t* w1 = (const bf16_t*)(p.ws + WS_CW1) + (size_t)kind * 128 * 4096 + (size_t)(wave * 16 + fr) * 4096 + fq * 8;
    const bf16_t* w2 = (const bf16_t*)(p.ws + WS_CW2) + (size_t)kind * 128 * 128 + (size_t)(wave * 16 + fr) * 128 + fq * 8;
    constexpr int NR = 528;
    unsigned char* At = lds;
    bf16_t* hid = (bf16_t*)lds;
    for (int i = tid; i < NR * 16; i += NTHR) { const int r = i >> 4, ch = i & 15; int tk = ct * 512 + r; tk = tk < SEQ ? tk : SEQ - 1;
        *(bf16x8*)(At + r * 256 + ((ch ^ ((r >> 4) & 15)) << 4)) = *(const bf16x8*)(proj + (size_t)tk * LDP + ch * 8); }
    __syncthreads();
    f32x4 a0 = {}, a1 = {};
    bf16x8 Ba[4], Bb[4], Bc[4];
#define CU_LDB(dst, l_) do { const bf16_t* wr_ = w1 + (l_) * 128; dst[0] = *(const bf16x8*)wr_; dst[1] = *(const bf16x8*)(wr_ + 32); dst[2] = *(const bf16x8*)(wr_ + 64); dst[3] = *(const bf16x8*)(wr_ + 96); } while (0)
#define CU_STEP(l_, Bx) do { const int r0 = 16 * fr + (l_), r1 = r0 + 256; const unsigned char* ar0 = At + r0 * 256; const unsigned char* ar1 = At + r1 * 256; const int sw = (r0 >> 4) & 15; \
        _Pragma("unroll") for (int s = 0; s < 4; ++s) { const int co = ((4 * s + fq) ^ sw) << 4; \
            a0 = __builtin_amdgcn_mfma_f32_16x16x32_bf16(*(const bf16x8*)(ar0 + co), Bx[s], a0, 0, 0, 0); a1 = __builtin_amdgcn_mfma_f32_16x16x32_bf16(*(const bf16x8*)(ar1 + co), Bx[s], a1, 0, 0, 0); } } while (0)
    CU_LDB(Ba, 0); CU_LDB(Bb, 1);
#pragma unroll 1
    for (int l = 0; l < 30; l += 3) {
        CU_LDB(Bc, l + 2); CU_STEP(l, Ba);
        CU_LDB(Ba, l + 3); CU_STEP(l + 1, Bb);
        CU_LDB(Bb, l + 4); CU_STEP(l + 2, Bc);
    }
    CU_STEP(30, Ba); CU_STEP(31, Bb);
#undef CU_LDB
#undef CU_STEP
    const float pb = ((const float*)(p.ws + WS_PEB))[kind * 128 + wave * 16 + fr];
    __syncthreads();
#pragma unroll
    for (int r = 0; r < 4; ++r) { float v0 = a0[r] + pb, v1 = a1[r] + pb; v0 = v0 * sigmoidf_(v0); v1 = v1 * sigmoidf_(v1);
        hid[(fq * 4 + r) * 136 + wave * 16 + fr] = f2bf(v0); hid[(16 + fq * 4 + r) * 136 + wave * 16 + fr] = f2bf(v1); }
    __syncthreads();
    f32x4 o0 = {}, o1 = {};
#pragma unroll
    for (int s = 0; s < 4; ++s) { const bf16x8 A0 = *(const bf16x8*)(hid + fr * 136 + s * 32 + fq * 8), A1 = *(const bf16x8*)(hid + (16 + fr) * 136 + s * 32 + fq * 8), Bf = *(const bf16x8*)(w2 + s * 32);
        o0 = __builtin_amdgcn_mfma_f32_16x16x32_bf16(A0, Bf, o0, 0, 0, 0); o1 = __builtin_amdgcn_mfma_f32_16x16x32_bf16(A1, Bf, o1, 0, 0, 0); }
    bf16_t* dst = (bf16_t*)(p.ws + (kind ? WS_VC : WS_KC)) + (size_t)((b * 2 + g) * 256) * 128 + wave * 16 + fr;
#pragma unroll
    for (int r = 0; r < 4; ++r) { const int ra = ct * 32 + fq * 4 + r, rb = ra + 16;
        dst[(size_t)ra * 128] = ra < 255 ? f2bf(o0[r]) : (bf16_t)0; dst[(size_t)rb * 128] = rb < 255 ? f2bf(o1[r]) : (bf16_t)0; }
    __syncthreads();
}
constexpr int AT_K = 3 * 16384, AT_WS = 81920, AT_SEL = 83968, AT_IMP = 86016, IMP_LD = 65;
template <int MODE>
__device__ __forceinline__ void attn_sweep(unsigned char* lds, const bf16_t* Kg, const bf16_t* Vg, int ld, int t_lo, int t_hi, const bf16x8 (&qr)[8],
                                           int tq, int qlo, unsigned long long selm, int qb, f32x16 (&o)[4], float& m_reg, float& l_reg) {
    const int tid = threadIdx.x, wid = __builtin_amdgcn_readfirstlane(tid >> 6), lane = tid & 63, r32 = lane & 31, hi = lane >> 5;
    const int sr = tid >> 4, sc = (tid & 15) * 8, vst0 = v_st(sr, sc), vst1 = v_st(32 + sr, sc), kws = KSWZ(sr, sc * 2);
    char* V_lds = (char*)lds; char* K_lds = (char*)lds + AT_K; LAS float* al_l = (LAS float*)(uintptr_t)(lds_addr(lds) + AT_WS + wid * 256);
    const int vb0 = lds_addr(V_lds) + v_rd_base(lane);
    bf16x8 st_k0, st_k1, st_v0, st_v1;
    if (t_lo >= t_hi) return;
#define AT_LOAD(t) do { const bf16_t* kp = Kg + (size_t)((t) * 64 + sr) * ld + sc; const bf16_t* vp = Vg + (size_t)((t) * 64 + sr) * ld + sc; \
        st_k0 = *(const bf16x8*)kp; st_k1 = *(const bf16x8*)(kp + (size_t)32 * ld); st_v0 = *(const bf16x8*)vp; st_v1 = *(const bf16x8*)(vp + (size_t)32 * ld); } while (0)
#define AT_WRITE(bf) do { *(bf16x8*)(K_lds + (bf) * SHM_K + kws) = st_k0; *(bf16x8*)(K_lds + (bf) * SHM_K + kws + 32 * 256) = st_k1; \
        *(bf16x8*)(V_lds + (bf) * SHM_V + vst0) = st_v0; *(bf16x8*)(V_lds + (bf) * SHM_V + vst1) = st_v1; } while (0)
#define AT_RESC(a) do { if (__any((a) < 1.f)) { if (hi == 0) al_l[r32] = (a); asm volatile("s_waitcnt lgkmcnt(0)" ::: "memory"); \
        _Pragma("unroll") for (int d_ = 0; d_ < 4; ++d_) _Pragma("unroll") for (int r = 0; r < 16; ++r) o[d_][r] *= al_l[crow(r, hi)]; } } while (0)
#define AT_STEP(t, BUF) do { const bool more_ = (t) + 1 < t_hi; if (more_) AT_LOAD((t) + 1); \
        const int kb_ = (t) * 64; bool act_ = true; bool on_ = true; \
        if (MODE == 1) { const unsigned sw_ = ((const LAS unsigned*)(uintptr_t)(lds_addr(lds) + AT_SEL))[(tq & 63) * 2 + ((t) >> 5)]; on_ = ((sw_ >> ((t) & 31)) & 1u) != 0u; act_ = __any(on_); } \
        if (act_) { f32x16 p0, p1; qkt<BUF, false>(p0, p1, K_lds, r32, hi, qr, true); \
            if (MODE == 2) { if (kb_ + 63 > qlo || kb_ <= qlo + 31 - 512) mask_tile(p0, p1, tq - 4 * hi - kb_, 512u); } \
            if (MODE == 1) { if ((t) == qb) mask_tile(p0, p1, tq - 4 * hi - kb_, 1u << 30); \
                if (!on_) { const float NEG_ = -__builtin_inff(); _Pragma("unroll") for (int r = 0; r < 16; ++r) { p0[r] = NEG_; p1[r] = NEG_; } } } \
            if (MODE == 0) { mask_tile(p0, p1, ((tq - 31) >> 4) - 4 * hi - kb_, 1u << 30); } \
            float mn_, alpha_; partialSM(p0, p1, m_reg, mn_, alpha_); AT_RESC(alpha_); \
            bf16x8 pa0, pa1, pa2, pa3; finishSM(p0, p1, alpha_, l_reg, pa0, pa1, pa2, pa3); SBAR(); \
            pv_tile<BUF, false>(o, vb0, pa0, pa1, pa2, pa3, true); } \
        if (more_) AT_WRITE((BUF) ^ 1); \
        __syncthreads(); } while (0)
    __syncthreads();
    AT_LOAD(t_lo); AT_WRITE(0); __syncthreads();
    for (int t = t_lo; t < t_hi; t += 2) {
        AT_STEP(t, 0);
        if (t + 1 < t_hi) AT_STEP(t + 1, 1);
    }
#undef AT_LOAD
#undef AT_WRITE
#undef AT_RESC
#undef AT_STEP
}

template <int MODE>
__device__ __forceinline__ void attn_sweep3(unsigned char* lds, const bf16_t* Kg, const bf16_t* Vg, int ld, int t_lo, int t_hi, const bf16x8 (&qr)[8],
                                            int tq, int qlo, unsigned long long selm, int qb, f32x16 (&o)[4], float& m_reg, float& l_reg, int var = 0, float* ir = nullptr, float* mt = nullptr) {
    (void)selm;
    int tid = threadIdx.x; asm volatile("" : "+v"(tid));
    const int wid = __builtin_amdgcn_readfirstlane(tid >> 6), lane = tid & 63, r32 = lane & 31, hi = lane >> 5;
    const unsigned lbase = (unsigned)lds_addr(lds);
    LAS float* al_l = (LAS float*)(uintptr_t)(lbase + AT_WS + wid * 256);
    const int vb0 = (int)lbase + v_rd_base(lane);
    const int NT = t_hi - t_lo; if (NT <= 0) return;
    int ko[2], vo[2];
#pragma unroll
    for (int j = 0; j < 2; ++j) { const int pz = j * 512 + tid; const int row = pz >> 4, ch = (pz & 15) ^ (row & 15); ko[j] = row * ld + ch * 8;
        const int kk = (pz >> 7) * 8 + ((pz & 31) >> 2), k = (kk & ~0xC) | ((kk & 4) << 1) | ((kk & 8) >> 1), c0 = ((pz >> 5) & 3) * 32 + (pz & 3) * 8; vo[j] = k * ld + c0; }
#define S3_DMA(i, kbo, vbo) do { const bf16_t* kt_ = Kg + (size_t)((t_lo + (i)) * 64) * ld; const bf16_t* vt_ = Vg + (size_t)((t_lo + (i)) * 64) * ld; \
        _Pragma("unroll") for (int j = 0; j < 2; ++j) { \
            __builtin_amdgcn_global_load_lds((const unsigned*)(kt_ + ko[j]), (LAS unsigned*)(uintptr_t)(lbase + AT_K + (kbo) + j * 8192 + wid * 1024), 16, 0, 0); \
            __builtin_amdgcn_global_load_lds((const unsigned*)(vt_ + vo[j]), (LAS unsigned*)(uintptr_t)(lbase + (vbo) + j * 8192 + wid * 1024), 16, 0, 0); } } while (0)
    __syncthreads();
    S3_DMA(0, 0u, 0);
    asm volatile("s_waitcnt vmcnt(0)" ::: "memory");
    __syncthreads();
    bf16x8 pa0 = {}, pa1 = {}, pa2 = {}, pa3 = {}; bool prev_act = false;
    int vprev = 0, vcur = 0, vnext = 16384;
    float carry_ = 0.f, mprev_ = 0.f;
    for (int i = 0; i < NT; ++i) {
        const int t = t_lo + i, kb_ = t * 64; const unsigned kcur = (unsigned)(i & 1) * 16384u;
        if (i + 1 < NT && !(var & 8)) S3_DMA(i + 1, (unsigned)((i + 1) & 1) * 16384u, vnext);
        bool act_ = true, on_ = true;
        if (MODE == 1) { const unsigned sw_ = ((const LAS unsigned*)(uintptr_t)(lbase + AT_SEL))[(tq & 63) * 2 + (t >> 5)]; on_ = ((sw_ >> (t & 31)) & 1u) != 0u; act_ = __any(on_); }
        f32x16 p0, p1;
        if (act_) { if (!(var & 1)) qkt_rt(p0, p1, lbase + AT_K + kcur, r32, hi, qr); else { p0 = f32x16{}; p1 = f32x16{}; } }
        if (prev_act && !(var & 2)) pv_tile<0, false>(o, vb0 + vprev, pa0, pa1, pa2, pa3, true);
        if (act_ && !(var & 4)) {
            if (MODE == 2) { if (kb_ + 63 > qlo || kb_ <= qlo + 31 - 512) mask_tile(p0, p1, tq - 4 * hi - kb_, 512u); }
            if (MODE == 1) { if (t == qb) mask_tile(p0, p1, tq - 4 * hi - kb_, 1u << 30);
                if (!on_) { const float NEG_ = -__builtin_inff();
#pragma unroll
                    for (int r = 0; r < 16; ++r) { p0[r] = NEG_; p1[r] = NEG_; } } }
            if (MODE == 0) { mask_tile(p0, p1, ((tq - 31) >> 4) - 4 * hi - kb_, 1u << 30); }
            float mn_, alpha_; partialSM(p0, p1, m_reg, mn_, alpha_);
            if (__any(alpha_ < 1.f)) { if (hi == 0) al_l[r32] = alpha_; asm volatile("s_waitcnt lgkmcnt(0)" ::: "memory");
#pragma unroll
                for (int d_ = 0; d_ < 4; ++d_)
#pragma unroll
                    for (int r = 0; r < 16; ++r) o[d_][r] *= al_l[crow(r, hi)]; }
            finishSM(p0, p1, alpha_, l_reg, pa0, pa1, pa2, pa3);
            if (MODE == 0 && ir != nullptr) {
                constexpr float C2i = 1.4426950408889634f * SCALE;
                float s4[8], lastv[8];
#pragma unroll
                for (int g4 = 0; g4 < 4; ++g4) { s4[g4] = (p0[4 * g4] + p0[4 * g4 + 1]) + (p0[4 * g4 + 2] + p0[4 * g4 + 3]); lastv[g4] = p0[4 * g4 + 3];
                    s4[4 + g4] = (p1[4 * g4] + p1[4 * g4 + 1]) + (p1[4 * g4 + 2] + p1[4 * g4 + 3]); lastv[4 + g4] = p1[4 * g4 + 3]; }
                const float cin = carry_ > 0.f ? carry_ * __builtin_amdgcn_exp2f((mprev_ - mn_) * C2i) : 0.f;
#pragma unroll
                for (int gi = 0; gi < 8; ++gi) { const float snd = hi ? (gi > 0 ? lastv[gi - 1] : cin) : lastv[gi]; const float rcv = __shfl_xor(snd, 32);
                    ir[16 * i + 2 * gi + hi] = s4[gi] + rcv; }
                carry_ = lastv[7]; mprev_ = mn_;
                if (i == 0) mt[0] = mn_; else if (i == 1) mt[1] = mn_; else if (i == 2) mt[2] = mn_; else mt[3] = mn_;
            }
        }
        prev_act = act_;
        vprev = vcur; vcur = vnext; vnext = vnext == 32768 ? 0 : vnext + 16384;
        asm volatile("s_waitcnt vmcnt(0)" ::: "memory");
        if (!(var & 128)) __syncthreads();
    }
    if (prev_act) pv_tile<0, false>(o, vb0 + vprev, pa0, pa1, pa2, pa3, true);
#undef S3_DMA
}

template <int MODE>
__device__ __forceinline__ void attn_sweep2(unsigned char* lds, const bf16_t* Kg, const bf16_t* Vg, int ld, int t_lo, int t_hi, const bf16x8 (&qr)[8],
                                            int tq, int qlo, unsigned long long selm, int qb, f32x16 (&o)[4], float& m_reg, float& l_reg) {
    const int tid = threadIdx.x, wid = __builtin_amdgcn_readfirstlane(tid >> 6), lane = tid & 63, r32 = lane & 31, hi = lane >> 5;
    const int sr = tid >> 4, sc = (tid & 15) * 8, vst0 = v_st(sr, sc), vst1 = v_st(32 + sr, sc), kws = KSWZ(sr, sc * 2);
    char* V_lds = (char*)lds; char* K_lds = (char*)lds + AT_K; float* al_l = (float*)(lds + AT_WS) + wid * 64;
    const int vb0 = lds_addr(V_lds) + v_rd_base(lane);
    const int NT = t_hi - t_lo; if (NT <= 0) return;
    bf16x8 st_k0, st_k1, st_v0, st_v1;
#define S2_LOAD(t) do { const bf16_t* kp = Kg + (size_t)((t_lo + (t)) * 64 + sr) * ld + sc; const bf16_t* vp = Vg + (size_t)((t_lo + (t)) * 64 + sr) * ld + sc; \
        st_v0 = *(const bf16x8*)vp; st_v1 = *(const bf16x8*)(vp + (size_t)32 * ld); st_k0 = *(const bf16x8*)kp; st_k1 = *(const bf16x8*)(kp + (size_t)32 * ld); } while (0)
#define S2_WRITE(bf) do { *(bf16x8*)(V_lds + (bf) * SHM_V + vst0) = st_v0; *(bf16x8*)(V_lds + (bf) * SHM_V + vst1) = st_v1; \
        *(bf16x8*)(K_lds + (bf) * SHM_K + kws) = st_k0; *(bf16x8*)(K_lds + (bf) * SHM_K + kws + 32 * 256) = st_k1; } while (0)
#define S2_VMW() asm volatile("s_waitcnt vmcnt(0)" ::: "memory")
#define S2_RESC(a) do { if (__any((a) < 1.f)) { if (hi == 0) al_l[r32] = (a); asm volatile("s_waitcnt lgkmcnt(0)" ::: "memory"); \
        _Pragma("unroll") for (int d_ = 0; d_ < 4; ++d_) _Pragma("unroll") for (int r = 0; r < 16; ++r) o[d_][r] *= al_l[crow(r, hi)]; } } while (0)
#define S2_MASK(PX0, PX1, t) do { const int kb_ = (t_lo + (t)) * 64; \
        if (MODE == 2) { if (kb_ + 63 > qlo || kb_ <= qlo + 31 - 512) mask_tile(PX0, PX1, tq - 4 * hi - kb_, 512u); } \
        if (MODE == 1) { if (t_lo + (t) == qb) mask_tile(PX0, PX1, tq - 4 * hi - kb_, 1u << 30); \
            if (!((selm >> (t_lo + (t))) & 1ull)) { const float NEG_ = -__builtin_inff(); _Pragma("unroll") for (int r = 0; r < 16; ++r) { PX0[r] = NEG_; PX1[r] = NEG_; } } } \
        if (MODE == 0) { mask_tile(PX0, PX1, ((tq - 31) >> 4) - 4 * hi - kb_, 1u << 30); } } while (0)
    f32x16 pA0, pA1, pB0, pB1; float mnA, mnB, alA, alB; bf16x8 pa0, pa1, pa2, pa3;
    __syncthreads();
    S2_LOAD(0); S2_VMW(); S2_WRITE(0); SBAR();
    if (NT > 1) S2_LOAD(1);
    __syncthreads();
    SBAR(); qkt<0, false>(pA0, pA1, K_lds, r32, hi, qr, true);
    S2_MASK(pA0, pA1, 0); partialSM(pA0, pA1, m_reg, mnA, alA);
    if (NT > 1) { S2_VMW(); S2_WRITE(1); }
    __syncthreads();
#define S2_HALF(PX0, PX1, mnX, alX, PY0, PY1, alY, t, KB, VB, SB) do { \
        SBAR(); qkt<KB, false>(PX0, PX1, K_lds, r32, hi, qr, true); \
        finishSM(PY0, PY1, alY, l_reg, pa0, pa1, pa2, pa3); SBAR(); \
        if ((t) + 1 < NT) { S2_LOAD((t) + 1); SBAR(); } \
        pv_tile<VB, false>(o, vb0, pa0, pa1, pa2, pa3, true); S2_MASK(PX0, PX1, (t)); partialSM(PX0, PX1, m_reg, mnX, alX); \
        __syncthreads(); \
        if ((t) + 1 < NT) { S2_VMW(); S2_WRITE(SB); } \
        S2_RESC(alX); __syncthreads(); } while (0)
    for (int t = 1; t + 1 < NT; t += 2) {
        S2_HALF(pB0, pB1, mnB, alB, pA0, pA1, alA, t, 1, 0, 0);
        S2_HALF(pA0, pA1, mnA, alA, pB0, pB1, alB, t + 1, 0, 1, 1);
    }
    const bool even = (NT & 1) == 0;
    if (even) { SBAR(); qkt<1, false>(pB0, pB1, K_lds, r32, hi, qr, true); SBAR(); }
    finishSM(pA0, pA1, alA, l_reg, pa0, pa1, pa2, pa3); SBAR();
    pv_tile<0, false>(o, vb0, pa0, pa1, pa2, pa3, true);
    if (even) { S2_MASK(pB0, pB1, NT - 1); partialSM(pB0, pB1, m_reg, mnB, alB); S2_RESC(alB);
        finishSM(pB0, pB1, alB, l_reg, pa0, pa1, pa2, pa3); SBAR(); pv_tile<1, false>(o, vb0, pa0, pa1, pa2, pa3, true); }
    (void)mnA; (void)mnB;
#undef S2_LOAD
#undef S2_WRITE
#undef S2_VMW
#undef S2_RESC
#undef S2_MASK
#undef S2_HALF
}

#if defined(MK_SWEEP3)
#define ATTN_SWEEP attn_sweep3
#elif !defined(MK_SWEEP1)
#define ATTN_SWEEP attn_sweep2
#else
#define ATTN_SWEEP attn_sweep
#endif
__device__ __forceinline__ void attn_unit(const Params& p, unsigned char* lds, int b, int g, int qb, int var = 0) {
    int tid = threadIdx.x; asm volatile("" : "+v"(tid));
    const int wid = __builtin_amdgcn_readfirstlane(tid >> 6), lane = tid & 63, r32 = lane & 31, hi = lane >> 5;
    const int hh = wid >> 1, th = wid & 1, tq = qb * 64 + th * 32 + r32, qlo = qb * 64 + th * 32;
    const bf16_t* P = (const bf16_t*)(p.ws + WS_PROJ) + (size_t)b * SEQ * LDP;
    LAS float* al_l = (LAS float*)(uintptr_t)(lds_addr(lds) + AT_WS + wid * 256);
    bf16x8 qr[8];
#pragma unroll
    for (int d0 = 0; d0 < 8; ++d0) qr[d0] = *(const bf16x8*)(P + (size_t)tq * LDP + COL_Q + (4 * g + hh) * 128 + d0 * 16 + hi * 8);
    const bf16_t* gp = P + (size_t)tq * LDP + COL_GATE + (4 * g + hh) * 3;
    f32x16 o[4] = {}; float m_reg = -1e30f, l_reg = 0.f;
    const unsigned oacc_b = (unsigned)lds_addr(lds) + AT_IMP + wid * 8192 + r32 * 64;
    unsigned oa[4];
#pragma unroll
    for (int k = 0; k < 4; ++k) oa[k] = oacc_b + ((((2 * k + hi) ^ ((r32 >> 2) & 7))) << 3);
#define AT_BRANCH_END(gatev, FIRST) do { if (var & 32) { m_reg = -1e30f; l_reg = 0.f; break; } const float gs_ = (gatev) * (l_reg > 0.f ? 1.0f / l_reg : 0.f); if (hi == 0) al_l[r32] = gs_; asm volatile("s_waitcnt lgkmcnt(0)" ::: "memory"); \
        _Pragma("unroll") for (int k = 0; k < 4; ++k) { const f32x4 s_ = *(const LAS f32x4*)(al_l + 8 * k + 4 * hi); \
            _Pragma("unroll") for (int d_ = 0; d_ < 4; ++d_) { LAS u32x2* q_ = (LAS u32x2*)(uintptr_t)(oa[k] + d_ * 2048); \
                float v0_ = o[d_][4 * k] * s_[0], v1_ = o[d_][4 * k + 1] * s_[1], v2_ = o[d_][4 * k + 2] * s_[2], v3_ = o[d_][4 * k + 3] * s_[3]; \
                o[d_][4 * k] = 0.f; o[d_][4 * k + 1] = 0.f; o[d_][4 * k + 2] = 0.f; o[d_][4 * k + 3] = 0.f; \
                if (!(FIRST)) { const u32x2 w_ = *q_; v0_ += __uint_as_float(w_.x << 16); v1_ += __uint_as_float(w_.x & 0xffff0000u); v2_ += __uint_as_float(w_.y << 16); v3_ += __uint_as_float(w_.y & 0xffff0000u); } \
                u32x2 n_; n_.x = cvtpk(v0_, v1_); n_.y = cvtpk(v2_, v3_); *q_ = n_; } } \
        m_reg = -1e30f; l_reg = 0.f; } while (0)
    const bf16_t* kc = (const bf16_t*)(p.ws + WS_KC) + (size_t)((b * 2 + g) * 256) * 128; const bf16_t* vc = (const bf16_t*)(p.ws + WS_VC) + (size_t)((b * 2 + g) * 256) * 128;
    const int nct = (4 * qb + 2) / 64 + 1;
    float* imp = (float*)(lds + AT_IMP); unsigned long long* selmask = (unsigned long long*)(lds + AT_SEL);
    float* ir = imp + (hh * 64 + th * 32 + r32) * IMP_LD; float mt[4] = {0.f, 0.f, 0.f, 0.f};
    const bool need_imp = qb >= 16 && !(var & 16);
    if (need_imp) { __syncthreads();
        for (int i = tid; i < 4 * 64 * IMP_LD; i += NTHR) imp[i] = 0.f; }
    ATTN_SWEEP<0>(lds, kc, vc, 128, 0, nct, qr, tq, qlo, 0ull, qb, o, m_reg, l_reg, 0, need_imp ? ir : nullptr, mt);
    const unsigned long long selm = 0ull;
    if (!need_imp) { if (tid < 64) selmask[tid] = (2ull << qb) - 1ull; }
    else {
        constexpr float C2 = 1.4426950408889634f * SCALE; const float inv_l = l_reg > 0.f ? 1.0f / l_reg : 0.f;
#pragma unroll
        for (int ti = 0; ti < 4; ++ti) if (ti < nct) { const float f = __builtin_amdgcn_exp2f((mt[ti] - m_reg) * C2) * inv_l;
#pragma unroll
            for (int gi = 0; gi < 8; ++gi) ir[16 * ti + 2 * gi + hi] *= f; }
        __syncthreads();
        for (int tt = 0; tt < 8; ++tt) { const int tok = wid * 8 + tt; const int j = lane;
            const float v = ((imp[(0 * 64 + tok) * IMP_LD + j] + imp[(1 * 64 + tok) * IMP_LD + j]) + imp[(2 * 64 + tok) * IMP_LD + j]) + imp[(3 * 64 + tok) * IMP_LD + j];
            const bool cand = j >= 1 && j <= qb - 2; int rank = 0;
            for (int jj = 1; jj <= qb - 2; ++jj) { const float vj = __int_as_float(__builtin_amdgcn_readlane(__float_as_int(v), jj)); rank += (vj > v || (vj == v && jj < j)) ? 1 : 0; }
            const bool sel = (cand && rank < 13) || j == 0 || j == qb || j == qb - 1;
            const unsigned long long mk = __ballot(sel); if (lane == 0) selmask[tok] = mk; }
        __syncthreads();
    }
    AT_BRANCH_END(sigmoidf_(bf2f(gp[0])), true);
    ATTN_SWEEP<1>(lds, P + COL_KS + g * 128, P + COL_VS + g * 128, LDP, 0, qb + 1, qr, tq, qlo, selm, qb, o, m_reg, l_reg, var);
    AT_BRANCH_END(sigmoidf_(bf2f(gp[1])), false);
    ATTN_SWEEP<2>(lds, P + COL_KW + g * 128, P + COL_VW + g * 128, LDP, qb > 8 ? qb - 8 : 0, qb + 1, qr, tq, qlo, 0ull, qb, o, m_reg, l_reg, var);
    AT_BRANCH_END(sigmoidf_(bf2f(gp[2])), false);
#undef AT_BRANCH_END
    {
      const int cg = lane & 15; const unsigned tb = (unsigned)lds_addr(lds) + AT_IMP + wid * 8192 + cg * 512;
#pragma unroll
      for (int blk = 0; blk < 2; ++blk) { const int rg = (lane >> 4) + 4 * blk; u32x2 c[8];
#pragma unroll
          for (int j = 0; j < 8; ++j) c[j] = *(const LAS u32x2*)(uintptr_t)(tb + j * 64 + ((rg ^ ((2 * cg + (j >> 2)) & 7)) << 3));
          bf16_t* oc = (bf16_t*)(p.ws + WS_R3) + (size_t)(b * SEQ + qb * 64 + th * 32 + 4 * rg) * 2048 + (4 * g + hh) * 128 + cg * 8;
          u32x4 r0, r1, r2, r3;
#pragma unroll
          for (int m = 0; m < 4; ++m) { const unsigned ax = c[2 * m].x, bx_ = c[2 * m + 1].x, ay = c[2 * m].y, by = c[2 * m + 1].y;
              r0[m] = (ax & 0xffffu) | (bx_ << 16); r1[m] = (ax >> 16) | (bx_ & 0xffff0000u); r2[m] = (ay & 0xffffu) | (by << 16); r3[m] = (ay >> 16) | (by & 0xffff0000u); }
          *(u32x4*)oc = r0; *(u32x4*)(oc + 2048) = r1; *(u32x4*)(oc + 2 * 2048) = r2; *(u32x4*)(oc + 3 * 2048) = r3; } }
}
__device__ __forceinline__ void p7_rows_route(const Params& p, unsigned char* lds, bool dry, int part) {
    const int tid = threadIdx.x, lane = tid & 63, wave = tid >> 6, G = gridDim.x, fr = lane & 15, fq = lane >> 4;
    unsigned char* ws = p.ws; const float* mod = (const float*)(ws + WS_MOD);
    const float* x = p.in[0]; const float* gpost = p.in[6]; const float* gpre = p.in[7];
    const bf16_t* y = (const bf16_t*)(ws + WS_R4); bf16_t* h2 = (bf16_t*)(ws + WS_R3);
    float* pA = (float*)lds; float* pB = pA + 2048; float* pC = pB + 2048; float* r2s = (float*)(lds + 98304);
    float* scr = r2s + 64 + wave * (16 * 49);
    unsigned* cnt = (unsigned*)(ws + WS_CTL + CTL_CNT);
    int* toke = (int*)(ws + WS_TOKE); int* tokp = (int*)(ws + WS_TOKP); int* rtok = (int*)(ws + WS_RTOK); float* rwe = (float*)(ws + WS_RWE);
    for (int gi = blockIdx.x; gi < T / 64; gi += G) {
        const int b = (gi * 64) >> 12; const float* md = mod + b * 12288;
        __syncthreads();
        for (int i = tid; i < 2048; i += NTHR) { pA[i] = md[4096 + i] * gpost[i]; pB[i] = gpre[i] * (1.0f + md[8192 + i]); pC[i] = md[6144 + i]; }
        __syncthreads();
        const int row0 = gi * 64 + wave * 8;
        f32x4 xa[8], xb[8]; u32x2 ya[8], yb[8];
#define P7_LOAD(X, Y, row) do { const float* xr_ = x + (size_t)(row) * DM + lane * 4; const bf16_t* yr_ = y + (size_t)(row) * DM + lane * 4; \
        _Pragma("unroll") for (int e = 0; e < 8; ++e) { X[e] = *(const f32x4*)(xr_ + e * 256); Y[e] = *(const u32x2*)(yr_ + e * 256); } } while (0)
#define P7_PROC(X, Y, row) do { f32x4 yv[8]; float ss = 0.f; \
        _Pragma("unroll") for (int e = 0; e < 8; ++e) { yv[e] = (f32x4){bflo(Y[e].x), bfhi(Y[e].x), bflo(Y[e].y), bfhi(Y[e].y)}; ss += yv[e][0] * yv[e][0] + yv[e][1] * yv[e][1] + yv[e][2] * yv[e][2] + yv[e][3] * yv[e][3]; } \
        ss = wave_sum(ss); const float r1 = rsqrtf(ss * (1.0f / DM) + EPS); float s2 = 0.f; \
        _Pragma("unroll") for (int e = 0; e < 8; ++e) { const f32x4 av = *(const f32x4*)(pA + e * 256 + lane * 4); const f32x4 x1 = X[e] + av * (yv[e] * r1); yv[e] = x1; \
            *(f32x4*)(p.out + (size_t)(row) * DM + e * 256 + lane * 4) = x1; s2 += x1[0] * x1[0] + x1[1] * x1[1] + x1[2] * x1[2] + x1[3] * x1[3]; } \
        s2 = wave_sum(s2); const float rr = rsqrtf(s2 * (1.0f / DM) + EPS); if (lane == 0) r2s[(row) - gi * 64] = rr; \
        _Pragma("unroll") for (int e = 0; e < 8; ++e) { const f32x4 bv = *(const f32x4*)(pB + e * 256 + lane * 4), cv = *(const f32x4*)(pC + e * 256 + lane * 4); const f32x4 o = yv[e] * rr * bv + cv; \
            u32x2 w; w.x = cvtpk(o[0], o[1]); w.y = cvtpk(o[2], o[3]); *(u32x2*)(h2 + (size_t)(row) * DM + e * 256 + lane * 4) = w; } } while (0)
        if (part & 1) {
        P7_LOAD(xa, ya, row0);
#pragma unroll 1
        for (int j = 0; j < 8; j += 2) { P7_LOAD(xb, yb, row0 + j + 1); P7_PROC(xa, ya, row0 + j); if (j + 2 < 8) P7_LOAD(xa, ya, row0 + j + 2); P7_PROC(xb, yb, row0 + j + 1); }
        }
#undef P7_LOAD
#undef P7_PROC
        __syncthreads();
        if (part & 2) {
            const bf16_t* WRh = (const bf16_t*)(ws + WS_WR) + ((size_t)(b * 64 + wave * 8) * 3 * 64 + lane) * 8; const bf16_t* WRl = WRh + 393216; const float* BR = (const float*)(ws + WS_BR) + b * 48;
            const float* xr = p.out + (size_t)(gi * 64 + fr) * DM + wave * 256 + fq * 8;
            f32x4 acc[4][3] = {};
#pragma unroll 2
            for (int s = 0; s < 8; ++s) { const bf16_t* wh = WRh + (size_t)s * 1536; const bf16_t* wl = WRl + (size_t)s * 1536;
                const bf16x8 h0 = *(const bf16x8*)wh, h1 = *(const bf16x8*)(wh + 512), h2_ = *(const bf16x8*)(wh + 1024), l0 = *(const bf16x8*)wl, l1 = *(const bf16x8*)(wl + 512), l2 = *(const bf16x8*)(wl + 1024);
#pragma unroll
                for (int q = 0; q < 4; ++q) { const f32x4 xa_ = *(const f32x4*)(xr + (size_t)q * 16 * DM + s * 32), xb_ = *(const f32x4*)(xr + (size_t)q * 16 * DM + s * 32 + 4);
                    const bf16x8 xh = pack8(xa_, xb_); f32x4 ra_, rb_;
#pragma unroll
                    for (int j = 0; j < 4; ++j) { ra_[j] = xa_[j] - bf2f((unsigned short)xh[j]); rb_[j] = xb_[j] - bf2f((unsigned short)xh[4 + j]); }
                    const bf16x8 xl = pack8(ra_, rb_);
                    acc[q][0] = __builtin_amdgcn_mfma_f32_16x16x32_bf16(xh, h0, acc[q][0], 0, 0, 0); acc[q][1] = __builtin_amdgcn_mfma_f32_16x16x32_bf16(xh, h1, acc[q][1], 0, 0, 0); acc[q][2] = __builtin_amdgcn_mfma_f32_16x16x32_bf16(xh, h2_, acc[q][2], 0, 0, 0);
                    acc[q][0] = __builtin_amdgcn_mfma_f32_16x16x32_bf16(xl, h0, acc[q][0], 0, 0, 0); acc[q][1] = __builtin_amdgcn_mfma_f32_16x16x32_bf16(xl, h1, acc[q][1], 0, 0, 0); acc[q][2] = __builtin_amdgcn_mfma_f32_16x16x32_bf16(xl, h2_, acc[q][2], 0, 0, 0);
                    acc[q][0] = __builtin_amdgcn_mfma_f32_16x16x32_bf16(xh, l0, acc[q][0], 0, 0, 0); acc[q][1] = __builtin_amdgcn_mfma_f32_16x16x32_bf16(xh, l1, acc[q][1], 0, 0, 0); acc[q][2] = __builtin_amdgcn_mfma_f32_16x16x32_bf16(xh, l2, acc[q][2], 0, 0, 0); } }
            float* psum = (float*)lds;
#pragma unroll
            for (int q = 0; q < 4; ++q)
#pragma unroll
                for (int cb = 0; cb < 3; ++cb) *(f32x4*)(psum + ((wave * 4 + q) * 3 + cb) * 256 + lane * 4) = acc[q][cb];
            __syncthreads();
            const int rbl = wave, rb = gi * 4 + rbl;
            if (wave < 4) { f32x4 a0 = {}, a1 = {}, a2 = {};
#pragma unroll
                for (int w = 0; w < 8; ++w) { a0 += *(const f32x4*)(psum + ((w * 4 + rbl) * 3 + 0) * 256 + lane * 4); a1 += *(const f32x4*)(psum + ((w * 4 + rbl) * 3 + 1) * 256 + lane * 4); a2 += *(const f32x4*)(psum + ((w * 4 + rbl) * 3 + 2) * 256 + lane * 4); }
#pragma unroll
            for (int r = 0; r < 4; ++r) { const int row = fq * 4 + r; const float rr = r2s[rbl * 16 + row];
                scr[row * 49 + fr] = a0[r] * rr + BR[fr]; scr[row * 49 + 16 + fr] = a1[r] * rr + BR[16 + fr]; scr[row * 49 + 32 + fr] = a2[r] * rr + BR[32 + fr]; }
            asm volatile("s_waitcnt lgkmcnt(0)" ::: "memory");
            if (lane < 16) { const float* lg = scr + lane * 49; const int tok = rb * 16 + lane;
                int gs = 0; float gm = lg[0];
#pragma unroll
                for (int i = 1; i < 4; ++i) if (lg[i] > gm) { gm = lg[i]; gs = i; }
                float den = 0.f;
#pragma unroll
                for (int i = 0; i < 4; ++i) den += expf(lg[i] - gm);
                const float pg = 1.0f / den;
                const float* le = lg + 4 + gs * 8; int i1 = 0; float v1 = le[0];
#pragma unroll
                for (int i = 1; i < 8; ++i) if (le[i] > v1) { v1 = le[i]; i1 = i; }
                int i2 = i1 == 0 ? 1 : 0; float v2 = -__builtin_inff();
#pragma unroll
                for (int i = 0; i < 8; ++i) if (i != i1 && le[i] > v2) { v2 = le[i]; i2 = i; }
                const float e2 = expf(v2 - v1), w1 = pg / (1.0f + e2), w2 = pg * e2 / (1.0f + e2);
                const int ea = gs * 8 + i1, eb = gs * 8 + i2;
                if (dry) { if (w1 == 123.456f) toke[0] = ea + eb; } else {
                const unsigned pa = atomicAdd(cnt + ea, 1u), pb = atomicAdd(cnt + eb, 1u);
                toke[tok * 2] = ea; toke[tok * 2 + 1] = eb; tokp[tok * 2] = (int)pa; tokp[tok * 2 + 1] = (int)pb;
                rtok[ea * 16384 + pa] = tok; rtok[eb * 16384 + pb] = tok; rwe[ea * 16384 + pa] = w1; rwe[eb * 16384 + pb] = w2; } }
            }
        }
    }
}
__device__ __forceinline__ void moe_toff(const Params& p, int* toff) {
    const int tid = threadIdx.x;
    __syncthreads();
    if (tid < 64) { const unsigned* cnt = (const unsigned*)(p.ws + WS_CTL + CTL_CNT);
        const int c = tid < 32 ? (int)__hip_atomic_load(cnt + tid, __ATOMIC_RELAXED, __HIP_MEMORY_SCOPE_AGENT) : 0; const int nt = (c + 255) >> 8;
        int incl = nt;
#pragma unroll
        for (int o = 1; o < 32; o <<= 1) { const int v = __shfl_up(incl, o); if ((tid & 63) >= o) incl += v; }
        if (tid < 32) { toff[tid] = incl - nt; toff[48 + tid] = c; } if (tid == 31) toff[32] = incl; }
    __syncthreads();
    const int ntile = toff[32];
    if (tid < 160) { int e = 0; bool tiny = false;
        if (tid < ntile) { while (toff[e + 1] <= tid) ++e; tiny = toff[48 + e] - (tid - toff[e]) * 256 <= 128; toff[256 + tid] = e; }
        toff[416 + tid] = (tid < ntile && !tiny) ? 1 : 0; }
    __syncthreads();
    if (tid < ntile) { int nfull = 0, before_full = 0;
        for (int k = 0; k < ntile; ++k) { const int f = toff[416 + k]; nfull += f; if (k < tid) before_full += f; }
        const bool full = toff[416 + tid] != 0; const int pos = full ? before_full : nfull + (tid - before_full);
        toff[96 + pos] = tid; }
    __syncthreads();
}
__device__ __forceinline__ void p11_final(const Params& p, const int* toff, unsigned char* lds, bool dry) {
    const int tid = threadIdx.x, lane = tid & 63, wave = tid >> 6, G = gridDim.x;
    unsigned char* ws = p.ws; const float* mod = (const float*)(ws + WS_MOD); const float* gpost = p.in[8];
    const bf16_t* yd = (const bf16_t*)(ws + WS_YD); const int* toke = (const int*)(ws + WS_TOKE); const int* tokp = (const int*)(ws + WS_TOKP);
    float* pD = (float*)lds;
    for (int gi = blockIdx.x; gi < T / 64; gi += G) {
        const int b = (gi * 64) >> 12; const float* md = mod + b * 12288;
        __syncthreads();
        for (int i = tid; i < 2048; i += NTHR) pD[i] = md[10240 + i] * gpost[i];
        __syncthreads();
        const int row0 = gi * 64 + wave * 8;
        int ra[8], rb[8];
#pragma unroll
        for (int j = 0; j < 8; ++j) { const int t2 = (row0 + j) * 2; ra[j] = toff[toke[t2]] * 256 + tokp[t2]; rb[j] = toff[toke[t2 + 1]] * 256 + tokp[t2 + 1]; }
        f32x4 xa[8], xb[8]; u32x2 ya0[8], ya1[8], yb0[8], yb1[8];
#define P11_LOAD(X, Y0, Y1, j) do { const float* xr_ = p.out + (size_t)(row0 + (j)) * DM + lane * 4; const bf16_t* y0_ = yd + (size_t)ra[j] * DM + lane * 4; const bf16_t* y1_ = yd + (size_t)rb[j] * DM + lane * 4; \
        _Pragma("unroll") for (int e = 0; e < 8; ++e) { X[e] = *(const f32x4*)(xr_ + e * 256); Y0[e] = *(const u32x2*)(y0_ + e * 256); Y1[e] = *(const u32x2*)(y1_ + e * 256); } } while (0)
#define P11_PROC(X, Y0, Y1, j) do { f32x4 yv[8]; float ss = 0.f; \
        _Pragma("unroll") for (int e = 0; e < 8; ++e) { yv[e] = (f32x4){bflo(Y0[e].x) + bflo(Y1[e].x), bfhi(Y0[e].x) + bfhi(Y1[e].x), bflo(Y0[e].y) + bflo(Y1[e].y), bfhi(Y0[e].y) + bfhi(Y1[e].y)}; \
            ss += yv[e][0] * yv[e][0] + yv[e][1] * yv[e][1] + yv[e][2] * yv[e][2] + yv[e][3] * yv[e][3]; } \
        ss = wave_sum(ss); const float r1 = rsqrtf(ss * (1.0f / DM) + EPS); \
        _Pragma("unroll") for (int e = 0; e < 8; ++e) { const f32x4 dv = *(const f32x4*)(pD + e * 256 + lane * 4); const f32x4 o_ = X[e] + dv * (yv[e] * r1); if (!dry) *(f32x4*)(p.out + (size_t)(row0 + (j)) * DM + e * 256 + lane * 4) = o_; else if (o_[0] == 123.456f) *(float*)(p.ws + WS_END) = o_[1]; } } while (0)
        P11_LOAD(xa, ya0, ya1, 0);
        P11_LOAD(xb, yb0, yb1, 1); P11_PROC(xa, ya0, ya1, 0); P11_LOAD(xa, ya0, ya1, 2); P11_PROC(xb, yb0, yb1, 1);
        P11_LOAD(xb, yb0, yb1, 3); P11_PROC(xa, ya0, ya1, 2); P11_LOAD(xa, ya0, ya1, 4); P11_PROC(xb, yb0, yb1, 3);
        P11_LOAD(xb, yb0, yb1, 5); P11_PROC(xa, ya0, ya1, 4); P11_LOAD(xa, ya0, ya1, 6); P11_PROC(xb, yb0, yb1, 5);
        P11_LOAD(xb, yb0, yb1, 7); P11_PROC(xa, ya0, ya1, 6); P11_PROC(xb, yb0, yb1, 7);
#undef P11_LOAD
#undef P11_PROC
    }
}
constexpr int N_PHASES = 11;
__global__ void __launch_bounds__(NTHR, 2) mk_fwd(Params p) {
    extern __shared__ __attribute__((aligned(16))) unsigned char lds[];
    const int tid = threadIdx.x, G = gridDim.x, bx = blockIdx.x;
    for (int u = tid; u < (LDS_BYTES - MISC_OFF) / 4; u += NTHR) ((unsigned*)(lds + MISC_OFF))[u] = 0u;
    __syncthreads();
    XcdBarrier bar = xcd_barrier_post((unsigned*)(p.ws + WS_CTL), (volatile LAS unsigned*)(lds + MISC_OFF));
    int* toff = (int*)(lds + MISC_OFF + 64);
    unsigned char* ws = p.ws;
    const int lo = p.ph_lo, hi = p.ph_hi;
#ifndef MK_ONLY
#define MK_ONLY -1
#endif
#define IN(k) ((MK_ONLY < 0 || MK_ONLY == (k)) && lo <= (k) && (k) < hi)
#ifndef MK_BAR2
#define MK_BAR2 0
#endif
#define SEAM(k) do { if (IN(k) && IN((k) + 1)) { xcd_barrier(bar); if (MK_BAR2) xcd_barrier(bar); } } while (0)
#ifndef MK_DUPMASK
#define MK_DUPMASK 0
#endif
#define REP(k) for (int rep_ = 0; rep_ < (((MK_DUPMASK >> (k)) & 1) ? 2 : 1); ++rep_)
    if (IN(0)) REP(0) { p0_prologue(p, lds); } SEAM(0);
    if (IN(1)) REP(1) { p1_norm1(p, lds); } SEAM(1);
    if (IN(2)) REP(2) { pg8::Gemm g{(const bf16_t*)(ws + WS_R3), (const bf16_t*)(ws + WS_W1T), T, 6656, 2048}; pg8::StaticOrder S; S.init(T, 6656, G, bx);
        pg8::EpiProj E{(bf16_t*)(ws + WS_PROJ), LDP, 0x15Fu  , (const float*)(ws + WS_COS), (const float*)(ws + WS_SIN)};
        pg8::gemm_phase<pg8::EpiProj, pg8::StaticOrder, true, true>((PG8_LAS unsigned char*)lds, g, S, E);
        { const int rem = S.nwg % G;
          if (rem != 0 && bx >= rem) { gates_pass(p, bx - rem, G - rem); xpose_tiles(p, lds, XT_GU0, XT_GU0 + XT_GU_TAIL1, bx - rem, G - rem); }
          else if (rem == 0) { gates_pass(p, bx, G); xpose_tiles(p, lds, XT_GU0, XT_GU0 + XT_GU_TAIL1, bx, G); } } } SEAM(2);
#ifndef MK_DRY
#define MK_DRY 0
#endif
    const bool dryok = p.ph_hi < 1000;
    if (IN(3)) { for (int rp_ = (MK_DRY & 2) ? 0 : 1; rp_ < 2; ++rp_) hgrn_h1_phase(p, lds, rp_ == 0 && dryok); } SEAM(3);
#ifndef MK_P4DUP
#define MK_P4DUP 0
#endif
    if (IN(4)) REP(4) {
        if (G >= 2) { if ((bx & 1) == 0) { for (int u = bx >> 1; u < 128; u += (G + 1) >> 1) compress_unit(p, lds, u); } else hgrn_h2_scan(p, bx >> 1, G >> 1); }
        else { for (int u = 0; u < 128; ++u) compress_unit(p, lds, u); hgrn_h2_scan(p, 0, 1); } } SEAM(4);
#ifndef MK_P5DUP
#define MK_P5DUP 0
#endif
#ifndef MK_AVAR
#define MK_AVAR 0
#endif
    if (IN(5)) REP(5) {
        for (int rp_ = 0; rp_ < ((MK_P5DUP & 1) ? 2 : 1); ++rp_) for (int it = bx; it < 256; it += G) { const int bg = it & 7, pr = it >> 3; const int var_ = ((MK_P5DUP & 1) && rp_ == 0 && p.ph_hi < 1000) ? MK_AVAR : 0;
#pragma unroll 1
            for (int k2 = 0; k2 < 2; ++k2) attn_unit(p, lds, bg >> 1, bg & 1, k2 ? 63 - pr : pr, var_); }
        __syncthreads();
#ifndef NO_H3
        for (int rp_ = 0; rp_ < ((MK_P5DUP & 2) ? 2 : 1); ++rp_) hgrn_h3_phase(p, lds);
#endif
        } SEAM(5);
    if (IN(6)) REP(6) { pg8::Gemm g{(const bf16_t*)(ws + WS_R3), (const bf16_t*)(ws + WS_W2T), T, 2048, 2048}; pg8::StaticOrder S; S.init(T, 2048, G, bx);
        pg8::EpiBf16 E{(bf16_t*)(ws + WS_R4), 2048, 7};
        pg8::gemm_phase<pg8::EpiBf16, pg8::StaticOrder, true, true>((PG8_LAS unsigned char*)lds, g, S, E); } SEAM(6);
    if (IN(7)) { for (int rp_ = (MK_DRY & (4 | 16 | 32)) ? 0 : 1; rp_ < 2; ++rp_) p7_rows_route(p, lds, rp_ == 0 && dryok, (rp_ == 0 && dryok) ? ((MK_DRY & 16) ? 1 : ((MK_DRY & 32) ? 2 : 3)) : 3); } SEAM(7);
    if (IN(8)) REP(8) { moe_toff(p, toff);
        pg8::Gemm g{(const bf16_t*)(ws + WS_R3), (const bf16_t*)(ws + WS_WGU), T, 32 * 1024, 2048}; pg8::MoeOrder S{(const PG8_LAS int*)toff, (const int*)(ws + WS_RTOK), 4, G, bx};
        pg8::EpiGateUp E{(bf16_t*)(ws + WS_HID), (const float*)(ws + WS_RWE), (const PG8_LAS int*)toff};
        pg8::gemm_phase<pg8::EpiGateUp, pg8::MoeOrder, true, true, true>((PG8_LAS unsigned char*)lds, g, S, E);
        { const int rem = (toff[32] * 4) % G; if (rem != 0 && bx >= rem) xpose_tiles(p, lds, XT_DN0, XT_CW0, bx - rem, G - rem); else if (rem == 0) xpose_tiles(p, lds, XT_DN0, XT_CW0, bx, G); } } SEAM(8);
    if (IN(9)) REP(9) { moe_toff(p, toff);
        pg8::Gemm g{(const bf16_t*)(ws + WS_HID), (const bf16_t*)(ws + WS_WD), 40960, 32 * 2048, 512}; pg8::MoeOrder S{(const PG8_LAS int*)toff, (const int*)(ws + WS_RTOK), 8, G, bx};
        pg8::EpiBf16 E{(bf16_t*)(ws + WS_YD), 2048, 7};
        pg8::gemm_phase<pg8::EpiBf16, pg8::MoeOrder, true, true>((PG8_LAS unsigned char*)lds, g, S, E); } SEAM(9);
    if (IN(10)) REP(10) { moe_toff(p, toff); for (int rp_ = (MK_DRY & 8) ? 0 : 1; rp_ < 2; ++rp_) p11_final(p, toff, lds, rp_ == 0 && dryok); }
#undef IN
#undef SEAM
}
}

#ifndef MK_MULTI
#define MK_MULTI 0
#endif
extern "C" void kernel_launch(void* const* d_in, const int* in_sizes, int n_in, void* d_out, int out_size, void* d_ws, size_t ws_size, hipStream_t stream) {
    using namespace mk;
    static int grid = 0;
    if (grid == 0) {
        if (n_in != 26 || out_size != T * DM || ws_size < WS_END) { fprintf(stderr, "kernel_launch: unexpected shapes (n_in %d out %d ws %zu need %zu)\n", n_in, out_size, ws_size, (size_t)WS_END); grid = -1; return; }
        int dev = 0, cus = 0, per_cu = 0;
        if (hipGetDevice(&dev) != hipSuccess || hipDeviceGetAttribute(&cus, hipDeviceAttributeMultiprocessorCount, dev) != hipSuccess) { grid = -1; return; }
        if (hipFuncSetAttribute((const void*)mk_fwd, hipFuncAttributeMaxDynamicSharedMemorySize, LDS_BYTES) != hipSuccess) { fprintf(stderr, "kernel_launch: hipFuncSetAttribute failed\n"); grid = -1; return; }
        if (hipOccupancyMaxActiveBlocksPerMultiprocessor(&per_cu, (const void*)mk_fwd, NTHR, LDS_BYTES) != hipSuccess || per_cu < 1) fprintf(stderr, "kernel_launch: occupancy query says %d\n", per_cu);
        (void)hipGetLastError();
        grid = cus;
    }
    if (grid < 0) return;
    (void)hipMemsetAsync((char*)d_ws + WS_CTL, 0, CTL_BYTES, stream);
    Params p{};
    for (int i = 0; i < 26; ++i) p.in[i] = (const float*)d_in[i];
    p.out = (float*)d_out; p.ws = (unsigned char*)d_ws;
#if MK_MULTI
#ifndef MK_EXTRAMASK
#define MK_EXTRAMASK 0
#endif
    for (int ph = 0; ph < N_PHASES; ++ph) { p.ph_lo = ph; p.ph_hi = ph + 1; hipLaunchKernelGGL(mk_fwd, dim3(grid), dim3(NTHR), LDS_BYTES, stream, p);
        if ((MK_EXTRAMASK >> ph) & 1) hipLaunchKernelGGL(mk_fwd, dim3(grid), dim3(NTHR), LDS_BYTES, stream, p); }
#else
    p.ph_lo = 0; p.ph_hi = N_PHASES; hipLaunchKernelGGL(mk_fwd, dim3(grid), dim3(NTHR), LDS_BYTES, stream, p);
#endif
}
```

```cpp
#include <hip/hip_runtime.h>
#include <hip/hip_bf16.h>
#include <cstdio>
#include <cstdint>
#define MK_SWEEP3 1
#define MK_SWZ15 1
#define MK_CHUNK_NPT 8
#define MK_ORDPAR 1
#define MK_HALFSKIP 1
#define MK_GU_P5 1
#define MK_NT 1
#define MK_NOBAR0 1
#define MK_DNNT 1
#define MK_PROJNT_ATT 1
#define MK_GU_SKEW 1
namespace pg8 {
#define PG8_LAS __attribute__((address_space(3)))
typedef unsigned short bf16_t;
typedef short bf16x8 __attribute__((ext_vector_type(8)));
typedef float f32x4 __attribute__((ext_vector_type(4)));
typedef unsigned u32x4 __attribute__((ext_vector_type(4)));
constexpr int BM = 256, BK = 64, HALF = 128, HTB = HALF * BK * 2  , STAGE_BYTES = 8 * HTB, NXCD = 8, WGM = 6;

__host__ __device__ __forceinline__ int lds_byte(int r, int c) { const int st = (r >> 4) * 2 + (c >> 5), rr = r & 15, cc = c & 31, ob = rr * 64 + cc * 2; return st * 1024 + (ob ^ (((ob >> 9) & 1) << 5)); }
__host__ __device__ __forceinline__ void stage_rc(int b, int& R, int& C) { const int st = b / 1024, sb = b % 1024, swz = sb ^ (((sb >> 9) & 1) << 5); R = (st >> 1) * 16 + swz / 64; C = (st & 1) * 32 + (swz % 64) / 2; }
__host__ __device__ __forceinline__ int perm32(int rho) { const int n = rho >> 4, i = rho & 15; return 8 * (i >> 2) + 4 * n + (i & 3); }

struct Unit { int pm, pn; };
struct Gemm { const bf16_t* A; const bf16_t* Bt; int M, N, K; };

struct StaticOrder {
    int nM, nN, nwg, G, c, wgm;
    __host__ __device__ void init(int M, int N, int G_, int c_, int wgm_ = WGM) { nM = M / BM; nN = N / BM; nwg = nM * nN; G = G_; c = c_; wgm = wgm_; }
    __host__ __device__ bool next(int i, Unit& u) const {
        const long L = (long)i * G + c; if (L >= nwg) return false;
        int wgid = (int)L; { const int q = nwg / NXCD, r = nwg % NXCD, xcd = wgid % NXCD, off = wgid / NXCD; wgid = (xcd < r ? xcd * (q + 1) : r * (q + 1) + (xcd - r) * q) + off; }
        const int nig = wgm * nN, gid = wgid / nig, fm = gid * wgm, gsz = (nM - fm) < wgm ? (nM - fm) : wgm;
        u.pm = fm + ((wgid % nig) % gsz); u.pn = (wgid % nig) / gsz; return true;
    }
    __device__ __forceinline__ void a_ready(const Unit&) const {}
    __device__ __forceinline__ void done(const Unit&) const {}
    __device__ __forceinline__ int arow(const Unit& u, int r) const { return u.pm * BM + r; }
    __device__ __forceinline__ bool half(const Unit&) const { return false; }
};
template <class Base> struct RangeOrder {
    Base S; int i0, n;
    __device__ __forceinline__ bool next(int i, Unit& u) const { return i < n && S.next(i0 + i, u); }
    __device__ __forceinline__ void a_ready(const Unit& u) const { S.a_ready(u); }
    __device__ __forceinline__ void done(const Unit& u) const { S.done(u); }
    __device__ __forceinline__ int arow(const Unit& u, int r) const { return S.arow(u, r); }
    __device__ __forceinline__ bool half(const Unit& u) const { return S.half(u); }
};
__device__ __forceinline__ unsigned cvt_pk_bf16(float lo, float hi) { unsigned r; asm volatile("v_cvt_pk_bf16_f32 %0, %1, %2" : "=v"(r) : "v"(lo), "v"(hi)); return r; }
#ifndef MK_CHUNK_NPT
#define MK_CHUNK_NPT 0
#endif
struct EpiBf16 {
    static constexpr bool PERM = true, AFTER_DRAIN = false;
    bf16_t* O; int ldc; int pnmask;
    __device__ __forceinline__ void operator()(const f32x4 (&acc)[2][2][4][2], const Unit& u, int wr, int wc, int fr, int fq) const {
        const int row0 = u.pm * BM + wr * 64 + fr; const int col0 = (u.pn & pnmask) * BM + wc * 32 + 8 * fq;
#pragma unroll
        for (int ai = 0; ai < 2; ++ai)
#pragma unroll
            for (int m = 0; m < 4; ++m) { bf16_t* rowp = O + (size_t)(row0 + ai * HALF + m * 16) * ldc + col0;
#pragma unroll
                for (int bj = 0; bj < 2; ++bj) { const f32x4 v0 = acc[ai][bj][m][0], v1 = acc[ai][bj][m][1];
                    u32x4 w; w.x = cvt_pk_bf16(v0[0], v0[1]); w.y = cvt_pk_bf16(v0[2], v0[3]); w.z = cvt_pk_bf16(v1[0], v1[1]); w.w = cvt_pk_bf16(v1[2], v1[3]);
                    *(u32x4*)(rowp + bj * HALF) = w; } }
    }
};
#if defined(MK_PROJNT)
#define PROJ_ST(v_, p_) __builtin_nontemporal_store((v_), (p_))
#elif defined(MK_PROJNT_ATT)
#define PROJ_ST(v_, p_) do { if (attcol_) __builtin_nontemporal_store((v_), (p_)); else *(p_) = (v_); } while (0)
#else
#define PROJ_ST(v_, p_) (*(p_) = (v_))
#endif
struct EpiProj {
    static constexpr bool PERM = true, AFTER_DRAIN = false;
    bf16_t* O; int ldc; unsigned ropemask; const float* cosT; const float* sinT;
    __device__ __forceinline__ void operator()(const f32x4 (&acc)[2][2][4][2], const Unit& u, int wr, int wc, int fr, int fq) const {
        const int row0 = u.pm * BM + wr * 64 + fr; const int col0 = u.pn * BM + wc * 32 + 8 * fq; const bool rope = (ropemask >> u.pn) & 1u; const int kk = 4 * wc + fq; const bool attcol_ = u.pn < 10 || u.pn == 26; (void)attcol_;
#pragma unroll
        for (int ai = 0; ai < 2; ++ai)
#pragma unroll
            for (int m = 0; m < 4; ++m) { const int row = row0 + ai * HALF + m * 16; bf16_t* rowp = O + (size_t)row * ldc + col0;
                f32x4 c = {1.f, 1.f, 1.f, 1.f}, s = {0.f, 0.f, 0.f, 0.f};
                if (rope) { c = *(const f32x4*)(cosT + (size_t)row * 64 + 4 * kk); s = *(const f32x4*)(sinT + (size_t)row * 64 + 4 * kk); }
#pragma unroll
                for (int bj = 0; bj < 2; ++bj) { const f32x4 a0 = acc[ai][bj][m][0], a1 = acc[ai][bj][m][1]; const f32x4 v0 = a0 * c - a1 * s, v1 = a1 * c + a0 * s;
                    u32x4 w; w.x = cvt_pk_bf16(v0[0], v0[1]); w.y = cvt_pk_bf16(v0[2], v0[3]); w.z = cvt_pk_bf16(v1[0], v1[1]); w.w = cvt_pk_bf16(v1[2], v1[3]);
                    PROJ_ST(w, (u32x4*)(rowp + bj * HALF)); } }
    }
};
struct EpiGateUp {
    static constexpr bool PERM = true, AFTER_DRAIN = false;
    bf16_t* H; const float* rwe; const PG8_LAS int* toff;
    __device__ __forceinline__ void operator()(const f32x4 (&acc)[2][2][4][2], const Unit& u, int wr, int wc, int fr, int fq) const {
        const int e = u.pn >> 2; const float* rwp = rwe + (size_t)e * 16384 + (u.pm - toff[e]) * BM;
        const int lrow0 = wr * 64 + fr; const int col0 = (u.pn & 3) * 128 + wc * 32 + 8 * fq;
#pragma unroll
        for (int ai = 0; ai < 2; ++ai)
#pragma unroll
            for (int m = 0; m < 4; ++m) { const int lrow = lrow0 + ai * HALF + m * 16; const float w = rwp[lrow]; float h[8];
#pragma unroll
                for (int n = 0; n < 2; ++n)
#pragma unroll
                    for (int e2 = 0; e2 < 4; ++e2) { const float g = acc[ai][0][m][n][e2], up = acc[ai][1][m][n][e2];
                        h[n * 4 + e2] = g * __builtin_amdgcn_rcpf(1.0f + __expf(-g)) * up * w; }
                u32x4 o; o.x = cvt_pk_bf16(h[0], h[1]); o.y = cvt_pk_bf16(h[2], h[3]); o.z = cvt_pk_bf16(h[4], h[5]); o.w = cvt_pk_bf16(h[6], h[7]);
                *(u32x4*)(H + (size_t)(u.pm * BM + lrow) * 512 + col0) = o; }
    }
};
struct MoeOrder {
    const PG8_LAS int* t; const int* rowtok; int npt, G, c;
    __device__ __forceinline__ bool next(int i, Unit& u) const {
        const long L = (long)i * G + c; const int ntiles = t[32]; const int total = ntiles * npt;
#ifdef MK_G3ROW
        if (npt == 4) {
            const int x = (int)(L % NXCD), off = (int)(L / NXCD); const int ti_ = 8 * (off >> 2) + x; if (ti_ >= ntiles) return false;
            const int tt_ = t[96 + ti_]; u.pm = tt_; u.pn = t[256 + tt_] * npt + (off & 3); return true; }
#endif
#ifdef MK_G3PAIR
        if (npt == 4) {
            const int x = (int)(L % NXCD), off = (int)(L / NXCD); const int ti_ = 4 * (off >> 1) + (x >> 1); if (ti_ >= ntiles) return false;
            const int tt_ = t[96 + ti_]; u.pm = tt_; u.pn = t[256 + tt_] * npt + 2 * (x & 1) + (off & 1); return true; }
#endif
        if (L >= (long)total) return false;
        int w = (int)L; if (npt == MK_CHUNK_NPT) { const int q = total / NXCD, r = total % NXCD, xcd = w % NXCD, off = w / NXCD; w = (xcd < r ? xcd * (q + 1) : r * (q + 1) + (xcd - r) * q) + off; }
        const int ti = t[96 + w / npt], p = w % npt;
        u.pm = ti; u.pn = t[256 + ti] * npt + p; return true;
    }
    __device__ __forceinline__ void a_ready(const Unit&) const {}
    __device__ __forceinline__ void done(const Unit&) const {}
    __device__ __forceinline__ int arow(const Unit& u, int r) const { const int e = u.pn / npt; const int q = (u.pm - t[e]) * BM + r; return q < t[48 + e] ? rowtok[(size_t)e * 16384 + q] : 0; }
    __device__ __forceinline__ bool half(const Unit& u) const { const int e = u.pn / npt; return t[48 + e] - (u.pm - t[e]) * BM <= HALF; }
};
template <class Epi, class Sched, bool ALIGN_EPI = false, bool SP2 = false, bool GATHER = false, bool HALFSKIP = false>
__device__ __forceinline__ void gemm_phase(PG8_LAS unsigned char* lds, const Gemm g, const Sched& S, const Epi& E) {
    const int tid = threadIdx.x, wid = __builtin_amdgcn_readfirstlane(tid >> 6), lane = tid & 63, wr = wid >> 2, wc = wid & 3, fr = lane & 15, fq = lane >> 4;
    const int K = g.K, nt = K / BK;
    unsigned voffA[2], voffB[2];
#pragma unroll
    for (int i = 0; i < 2; ++i) { int R, C; stage_rc(tid * 16 + i * 8192, R, C); const int Rb = Epi::PERM ? ((R & ~31) + perm32(R & 31)) : R;
        voffA[i] = (unsigned)(R * K + C) * 2u; voffB[i] = (unsigned)(Rb * K + C) * 2u; }
    unsigned cv0[2] = {0u, 0u}, cv1[2] = {0u, 0u}, nv0[2] = {0u, 0u}, nv1[2] = {0u, 0u}; int gR[2] = {0, 0}, gC[2] = {0, 0};
    if constexpr (GATHER) {
#pragma unroll
        for (int i = 0; i < 2; ++i) stage_rc(tid * 16 + i * 8192, gR[i], gC[i]); }
#define PG8_GVOFF(dst0, dst1, un) do { _Pragma("unroll") for (int _i = 0; _i < 2; ++_i) { dst0[_i] = (unsigned)(S.arow(un, gR[_i]) * K + gC[_i]) * 2u; dst1[_i] = (unsigned)(S.arow(un, HALF + gR[_i]) * K + gC[_i]) * 2u; } } while (0)
    const size_t kstep = (size_t)(BK * 2);
    const size_t hstep = (size_t)HALF * K * 2;
    const size_t tstep = 2 * hstep;
    const unsigned ldsw = (unsigned)wid * 1024u;
    const int aoff = lds_byte(wr * 64 + fr, fq * 8), boff = lds_byte(wc * 32 + fr, fq * 8);
#define PG8_SA(b, h) (((b) * 2 + (h)) * HTB)
#define PG8_SB(b, h) ((4 + (b) * 2 + (h)) * HTB)
#define PG8_STAGE(bufoff, gbase, voff) do { _Pragma("unroll") for (int _i = 0; _i < 2; ++_i) \
        __builtin_amdgcn_global_load_lds((const unsigned*)((const char*)(gbase) + (voff)[_i]), (PG8_LAS unsigned*)(lds + (bufoff) + ldsw + _i * 8192), 16, 0, 0); } while (0)
#define PG8_LDA(dst, b, h) do { _Pragma("unroll") for (int m = 0; m < 4; ++m) _Pragma("unroll") for (int k = 0; k < 2; ++k) dst[m][k] = *(const PG8_LAS bf16x8*)(lds + PG8_SA(b, h) + aoff + m * 2048 + k * 1024); } while (0)
#define PG8_LDB(dst, b, h) do { _Pragma("unroll") for (int n = 0; n < 2; ++n) _Pragma("unroll") for (int k = 0; k < 2; ++k) dst[n][k] = *(const PG8_LAS bf16x8*)(lds + PG8_SB(b, h) + boff + n * 2048 + k * 1024); } while (0)
#define PG8_MMA(ai, bj, At, Bt) do { __builtin_amdgcn_s_setprio(1); _Pragma("unroll") for (int m = 0; m < 4; ++m) _Pragma("unroll") for (int n = 0; n < 2; ++n) _Pragma("unroll") for (int k = 0; k < 2; ++k) \
        acc[ai][bj][m][n] = __builtin_amdgcn_mfma_f32_16x16x32_bf16(Bt[n][k], At[m][k], acc[ai][bj][m][n], 0, 0, 0); __builtin_amdgcn_s_setprio(0); } while (0)
#define PG8_WAIT_V(n) asm volatile("s_waitcnt vmcnt(" #n ")" ::: "memory")
#define PG8_WAIT_L(n) asm volatile("s_waitcnt lgkmcnt(" #n ")" ::: "memory")
#define PG8_BAR __builtin_amdgcn_s_barrier()
#define PG8_SCHED __builtin_amdgcn_sched_barrier(0)
    Unit cur, nxt; int ui = 0;
    if (!S.next(0, cur)) return;
    f32x4 acc[2][2][4][2];
#pragma unroll
    for (int a = 0; a < 2; ++a)
#pragma unroll
        for (int b = 0; b < 2; ++b)
#pragma unroll
            for (int m = 0; m < 4; ++m)
#pragma unroll
                for (int n = 0; n < 2; ++n) acc[a][b][m][n] = (f32x4){0.f, 0.f, 0.f, 0.f};
    bf16x8 At[4][2], B0[2][2], B1[2][2];
    const char* cA = (const char*)g.A + (GATHER ? (size_t)0 : (size_t)cur.pm * tstep); const char* cB = (const char*)g.Bt + (size_t)cur.pn * tstep;
    const size_t ahstep = GATHER ? (size_t)0 : hstep;
    S.a_ready(cur);
    bool halfu = false; if constexpr (HALFSKIP) halfu = S.half(cur);
    if constexpr (GATHER) { PG8_GVOFF(cv0, cv1, cur); }
    static_assert(!GATHER || SP2, "GATHER is wired into the SP2 loop only");
#define PG8_C0 (GATHER ? cv0 : voffA)
#define PG8_C1 (GATHER ? cv1 : voffA)
#define PG8_W0 (GATHER ? wa0 : voffA)
#define PG8_W1 (GATHER ? wa1 : voffA)
    if constexpr (SP2) {
        PG8_STAGE(PG8_SB(0, 0), cB, voffB); PG8_STAGE(PG8_SB(0, 1), cB + hstep, voffB); PG8_STAGE(PG8_SA(0, 0), cA, PG8_C0); PG8_STAGE(PG8_SA(0, 1), cA + ahstep, PG8_C1);
        if (wr == 1) PG8_BAR;
        PG8_WAIT_V(2); PG8_BAR;
        PG8_STAGE(PG8_SB(1, 0), cB + kstep, voffB); PG8_STAGE(PG8_SA(1, 0), cA + kstep, PG8_C0); PG8_STAGE(PG8_SB(1, 1), cB + hstep + kstep, voffB);
        PG8_WAIT_V(6); PG8_BAR;
    } else {
        PG8_STAGE(PG8_SB(0, 0), cB, voffB); PG8_STAGE(PG8_SA(0, 0), cA, voffA); PG8_STAGE(PG8_SB(0, 1), cB + hstep, voffB); PG8_STAGE(PG8_SA(0, 1), cA + hstep, voffA);
        if (wr == 1) PG8_BAR;
        PG8_WAIT_V(4); PG8_BAR;
        PG8_STAGE(PG8_SB(1, 0), cB + kstep, voffB); PG8_STAGE(PG8_SA(1, 0), cA + kstep, voffA); PG8_STAGE(PG8_SB(1, 1), cB + hstep + kstep, voffB);
        PG8_WAIT_V(6); PG8_BAR;
    }
    for (;;) {
        const bool has_next = S.next(ui + 1, nxt);
        const char* nA = (has_next && !GATHER) ? (const char*)g.A + (size_t)nxt.pm * tstep : cA; const char* nB = has_next ? (const char*)g.Bt + (size_t)nxt.pn * tstep : cB;
        if constexpr (GATHER) { if (has_next) { PG8_GVOFF(nv0, nv1, nxt); } else { nv0[0] = cv0[0]; nv0[1] = cv0[1]; nv1[0] = cv1[0]; nv1[1] = cv1[1]; } }
#define PG8_KLOOP(HS_) \
        for (int t = 0; t < nt; t += 2) { \
            const bool last = (t == nt - 2); \
            const char* a1 = cA + (size_t)(t + 1) * kstep; \
            const char* a2 = last ? nA : cA + (size_t)(t + 2) * kstep; const char* b2 = last ? nB : cB + (size_t)(t + 2) * kstep; \
            const char* a3 = a2 + kstep; const char* b3 = b2 + kstep; \
            if (last && has_next) S.a_ready(nxt); \
            unsigned wa0[2] = {0u, 0u}, wa1[2] = {0u, 0u}; \
            if constexpr (GATHER) { wa0[0] = last ? nv0[0] : cv0[0]; wa0[1] = last ? nv0[1] : cv0[1]; wa1[0] = last ? nv1[0] : cv1[0]; wa1[1] = last ? nv1[1] : cv1[1]; } \
            if constexpr (SP2) { \
 \
 \
            PG8_LDB(B0, 0, 0); PG8_LDB(B1, 0, 1); PG8_SCHED; PG8_LDA(At, 0, 0); PG8_STAGE(PG8_SA(1, 1), a1 + ahstep, PG8_C1); \
            PG8_WAIT_V(8); PG8_WAIT_L(0); PG8_BAR; PG8_MMA(0, 0, At, B0); PG8_MMA(0, 1, At, B1); PG8_BAR; PG8_SCHED; \
 \
            if (!(HS_)) PG8_LDA(At, 0, 1); PG8_STAGE(PG8_SB(0, 0), b2, voffB); PG8_STAGE(PG8_SB(0, 1), b2 + hstep, voffB); PG8_STAGE(PG8_SA(0, 0), a2, PG8_W0); \
            PG8_WAIT_V(8); PG8_WAIT_L(0); PG8_BAR; if (!(HS_)) { PG8_MMA(1, 0, At, B0); PG8_MMA(1, 1, At, B1); } PG8_BAR; PG8_SCHED; \
 \
            PG8_LDB(B0, 1, 0); PG8_LDB(B1, 1, 1); PG8_SCHED; PG8_LDA(At, 1, 0); PG8_STAGE(PG8_SA(0, 1), a2 + ahstep, PG8_W1); \
            PG8_WAIT_V(8); PG8_WAIT_L(0); PG8_BAR; PG8_MMA(0, 0, At, B0); PG8_MMA(0, 1, At, B1); PG8_BAR; PG8_SCHED; \
 \
            if (!(HS_)) PG8_LDA(At, 1, 1); PG8_STAGE(PG8_SB(1, 0), b3, voffB); PG8_STAGE(PG8_SB(1, 1), b3 + hstep, voffB); PG8_STAGE(PG8_SA(1, 0), a3, PG8_W0); \
            PG8_WAIT_V(8); PG8_WAIT_L(0); PG8_BAR; if (!(HS_)) { PG8_MMA(1, 0, At, B0); PG8_MMA(1, 1, At, B1); } PG8_BAR; PG8_SCHED; \
            } else { \
 \
            PG8_LDB(B0, 0, 0); PG8_SCHED; PG8_LDA(At, 0, 0); PG8_STAGE(PG8_SA(1, 1), a1 + hstep, voffA); \
            PG8_WAIT_L(8); PG8_BAR; PG8_WAIT_L(0); PG8_MMA(0, 0, At, B0); PG8_BAR; PG8_SCHED; \
 \
            PG8_LDB(B1, 0, 1); PG8_STAGE(PG8_SB(0, 0), b2, voffB); \
            PG8_BAR; PG8_WAIT_L(0); PG8_MMA(0, 1, At, B1); PG8_BAR; \
 \
            PG8_LDA(At, 0, 1); PG8_STAGE(PG8_SA(0, 0), a2, voffA); \
            PG8_BAR; PG8_WAIT_L(0); PG8_MMA(1, 0, At, B0); PG8_BAR; PG8_SCHED; \
 \
            PG8_STAGE(PG8_SB(0, 1), b2 + hstep, voffB); \
            PG8_WAIT_V(6); PG8_BAR; PG8_MMA(1, 1, At, B1); PG8_BAR; \
 \
            PG8_LDB(B0, 1, 0); PG8_SCHED; PG8_LDA(At, 1, 0); PG8_STAGE(PG8_SA(0, 1), a2 + hstep, voffA); \
            PG8_WAIT_L(8); PG8_BAR; PG8_WAIT_L(0); PG8_MMA(0, 0, At, B0); PG8_BAR; PG8_SCHED; \
 \
            PG8_LDB(B1, 1, 1); PG8_STAGE(PG8_SB(1, 0), b3, voffB); \
            PG8_BAR; PG8_WAIT_L(0); PG8_MMA(0, 1, At, B1); PG8_BAR; \
 \
            PG8_LDA(At, 1, 1); PG8_STAGE(PG8_SA(1, 0), a3, voffA); \
            PG8_BAR; PG8_WAIT_L(0); PG8_MMA(1, 0, At, B0); PG8_BAR; PG8_SCHED; \
 \
            PG8_STAGE(PG8_SB(1, 1), b3 + hstep, voffB); \
            PG8_WAIT_V(6); PG8_BAR; PG8_MMA(1, 1, At, B1); PG8_BAR; \
            } \
        }
        if (halfu) { PG8_KLOOP(1) } else { PG8_KLOOP(0) }
#undef PG8_KLOOP
        if constexpr (ALIGN_EPI) { if (wr == 0) PG8_BAR; }
        if constexpr (!Epi::AFTER_DRAIN) { E(acc, cur, wr, wc, fr, fq); S.done(cur); }
        if (!has_next) break;
#pragma unroll
        for (int a = 0; a < 2; ++a)
#pragma unroll
            for (int b = 0; b < 2; ++b)
#pragma unroll
                for (int m = 0; m < 4; ++m)
#pragma unroll
                    for (int n = 0; n < 2; ++n) acc[a][b][m][n] = (f32x4){0.f, 0.f, 0.f, 0.f};
        cur = nxt; cA = nA; cB = nB; ++ui;
        if constexpr (HALFSKIP) halfu = S.half(cur);
        if constexpr (GATHER) { cv0[0] = nv0[0]; cv0[1] = nv0[1]; cv1[0] = nv1[0]; cv1[1] = nv1[1]; }
        if constexpr (ALIGN_EPI) { if (wr == 1) PG8_BAR; }
    }
    PG8_WAIT_V(0);
    if constexpr (!ALIGN_EPI) { if (wr == 0) PG8_BAR; }
    PG8_BAR;
    if constexpr (Epi::AFTER_DRAIN) { E.fused(acc, cur, wr, wc, fr, fq, lds, wid, lane); S.done(cur); }
#undef PG8_SA
#undef PG8_GVOFF
#undef PG8_C0
#undef PG8_C1
#undef PG8_W0
#undef PG8_W1
#undef PG8_SB
#undef PG8_STAGE
#undef PG8_LDA
#undef PG8_LDB
#undef PG8_MMA
#undef PG8_WAIT_V
#undef PG8_WAIT_L
#undef PG8_BAR
#undef PG8_SCHED
}
}
#define XB_TMO      128
#define XB_XCNT(j)  (256  + 64 * (j))
#define XB_XSUB(j)  (1280 + 64 * (j))
#define XB_XGEN(j)  (2304 + 64 * (j))
#define XB_TOP      3328
#define XB_TOPGEN   3392
#define XCD_BAR_WORDS 3456
#define XB_SPIN_CAP (1u << 18)
#define LAS __attribute__((address_space(3)))

__device__ __forceinline__ unsigned xb_ld(unsigned* p)              { return __hip_atomic_load(p, __ATOMIC_RELAXED, __HIP_MEMORY_SCOPE_AGENT); }
__device__ __forceinline__ unsigned xb_add(unsigned* p, unsigned v) { return __hip_atomic_fetch_add(p, v, __ATOMIC_RELAXED, __HIP_MEMORY_SCOPE_AGENT); }
__device__ __forceinline__ unsigned xb_xcc_id() { return (unsigned)__builtin_amdgcn_s_getreg((3 << 11) | 20) & 0xFu; }
#define XB_SPIN(cond, bar) do { unsigned _sp = 0; while (cond) { __builtin_amdgcn_s_sleep(1); \
    if ((++_sp & 255u) == 0u) { if (xb_ld(&(bar)[XB_TMO])) break; if (_sp > XB_SPIN_CAP) { atomicAdd(&(bar)[XB_TMO], 1u); break; } } } } while (0)

struct XcdBarrier {
    unsigned* bar; unsigned x;
    volatile LAS unsigned* st;
};

__device__ __forceinline__ XcdBarrier xcd_barrier_post(unsigned* bar, volatile LAS unsigned* st) {
    XcdBarrier b; b.bar = bar; b.x = xb_xcc_id(); b.st = st;
    if (threadIdx.x == 0) (void)xb_add(&bar[XB_XCNT(b.x)], 1u);
    return b;
}
__device__ __forceinline__ void xcd_barrier_complete(unsigned* bar, unsigned x, unsigned& nloc, unsigned& nx) {
    const unsigned G = gridDim.x * gridDim.y * gridDim.z;
    unsigned sum, cnt, mine, sp = 0u;
    for (;;) {
        sum = 0u; cnt = 0u; mine = 0u;
#pragma unroll
        for (unsigned j = 0; j < 16; ++j) { const unsigned c = xb_ld(&bar[XB_XCNT(j)]); sum += c; cnt += (c > 0u) ? 1u : 0u; mine = (j == x) ? c : mine; }
        if (sum == G) break;
        __builtin_amdgcn_s_sleep(1);
        if ((++sp & 255u) == 0u) { if (xb_ld(&bar[XB_TMO])) break; if (sp > XB_SPIN_CAP) { atomicAdd(&bar[XB_TMO], 1u); break; } }
    }
    nloc = mine > 0u ? mine : 1u; nx = cnt > 0u ? cnt : 1u;
}

__device__ __forceinline__ void xcd_barrier(const XcdBarrier& b) {
    asm volatile("s_waitcnt vmcnt(0)" ::: "memory");
    __syncthreads();
    if (threadIdx.x == 0) {
        unsigned* bar = b.bar;
        __builtin_amdgcn_s_waitcnt(0);
        unsigned nloc = b.st[0], nx = b.st[1];
        if (nloc == 0u) { xcd_barrier_complete(bar, b.x, nloc, nx); b.st[0] = nloc; b.st[1] = nx; }
        const unsigned old = xb_add(&bar[XB_XSUB(b.x)], 1u);
        const unsigned gen = old / nloc;
        if (old + 1u == (gen + 1u) * nloc) {
            __builtin_amdgcn_fence(__ATOMIC_RELEASE, "agent");
            asm volatile("s_waitcnt vmcnt(0)" ::: "memory");
            const unsigned og = xb_add(&bar[XB_TOP], 1u);
            const unsigned tg = og / nx;
            if (og + 1u == (tg + 1u) * nx) xb_add(&bar[XB_TOPGEN], 1u);
            else XB_SPIN(xb_ld(&bar[XB_TOPGEN]) == tg, bar);
            __builtin_amdgcn_fence(__ATOMIC_ACQUIRE, "agent");
            xb_add(&bar[XB_XGEN(b.x)], 1u);
            asm volatile("s_waitcnt vmcnt(0)" ::: "memory");
        } else {
            XB_SPIN(xb_ld(&bar[XB_XGEN(b.x)]) == gen, bar);
            __builtin_amdgcn_fence(__ATOMIC_ACQUIRE, "agent");
            asm volatile("s_waitcnt vmcnt(0)" ::: "memory");
        }
    }
    __syncthreads();
}
#ifndef MK_TMODE
#define MK_TMODE 0
#endif
#if MK_TMODE == 4
#define TC_BEGIN(id) unsigned long long tcb_##id = 0ull; if (MK_TSEL == id && threadIdx.x == 0) tcb_##id = wall_clock64()
#define TC_END(id, lds_) do { if (MK_TSEL == id && threadIdx.x == 0) ((volatile unsigned long long*)((lds_) + MISC_OFF + 3072))[1] += wall_clock64() - tcb_##id; } while (0)
#else
#define TC_BEGIN(id) do {} while (0)
#define TC_END(id, lds_) do {} while (0)
#endif
#ifdef MK_NT
#define NTLD(p_) __builtin_nontemporal_load(p_)
#define NTST(v_, p_) __builtin_nontemporal_store((v_), (p_))
#else
#define NTLD(p_) (*(p_))
#define NTST(v_, p_) (*(p_) = (v_))
#endif
namespace mk {
using pg8::bf16_t; using pg8::bf16x8; using pg8::f32x4; using pg8::u32x4;
typedef short s16x4 __attribute__((ext_vector_type(4)));
typedef float f32x16 __attribute__((ext_vector_type(16)));
typedef unsigned u32x2 __attribute__((ext_vector_type(2)));

constexpr int DM = 2048, NB = 4, SEQ = 4096, T = NB * SEQ;
constexpr int LDP = 6912;
constexpr int COL_Q = 0, COL_KC = 1024, COL_VC = 1280, COL_KS = 1536, COL_VS = 1792, COL_KW = 2048, COL_VW = 2304,
              COL_HQ = 2560, COL_HF = 3584, COL_HI = 4608, COL_HG = 5632, COL_GATE = 6656;
constexpr float EPS = 1e-6f;
constexpr int NTHR = 512;
constexpr int LDS_BYTES = 159744;
constexpr int MISC_OFF = 155648;

constexpr size_t al256(size_t x) { return (x + 255) & ~(size_t)255; }
constexpr size_t WS_CTL = 0, CTL_BYTES = 32768;
constexpr size_t CTL_CNT = 16384;
constexpr size_t CTL_MODCNT = 20480;
constexpr size_t WS_MOD = WS_CTL + CTL_BYTES;
constexpr size_t WS_COS = WS_MOD + 4 * 12288 * 4;
constexpr size_t WS_SIN = WS_COS + (size_t)T * 64 * 4;
constexpr size_t WS_WR = WS_SIN + (size_t)T * 64 * 4;
constexpr size_t WS_BR = WS_WR + 4 * 2048 * 48 * 4;
constexpr size_t WS_LB = WS_BR + 1024;
constexpr size_t WS_PEB = WS_LB + 4096;
constexpr size_t WS_CW1 = WS_PEB + 1024;
constexpr size_t WS_CW2 = WS_CW1 + 2 * 128 * 4096 * 2;
constexpr size_t WS_KC = WS_CW2 + 2 * 128 * 128 * 2;
constexpr size_t WS_VC = WS_KC + 8 * 256 * 128 * 2;
constexpr size_t WS_DECAY = WS_VC + 8 * 256 * 128 * 2;
constexpr size_t WS_EBM = WS_DECAY + 2048 * 128 * 4;
constexpr size_t WS_R2 = WS_EBM + 2048 * 128 * 4;
constexpr size_t WS_TOKE = WS_R2 + T * 4;
constexpr size_t WS_TOKW = WS_TOKE + T * 8;
constexpr size_t WS_TOKP = WS_TOKW + T * 8;
constexpr size_t WS_RTOK = WS_TOKP + T * 8;
constexpr size_t WS_RWE = WS_RTOK + 32 * 16384 * 4;
constexpr size_t WS_W1T = al256(WS_RWE + 32 * 16384 * 4);
constexpr size_t WS_W2T = WS_W1T + (size_t)6912 * 2048 * 2;
constexpr size_t WS_PROJ = WS_W2T + (size_t)2048 * 2048 * 2;
constexpr size_t WS_HID = WS_PROJ, WS_YD = WS_PROJ + (size_t)48 * 1024 * 1024;
constexpr size_t WS_R3 = WS_PROJ + (size_t)T * LDP * 2;
constexpr size_t WS_R4 = WS_R3 + (size_t)T * 2048 * 2;
constexpr size_t WS_WGU = WS_R4 + (size_t)T * 2048 * 2;
constexpr size_t WS_WD = WS_WGU + (size_t)32 * 1024 * 2048 * 2;
constexpr size_t WS_END = WS_WD + (size_t)32 * 2048 * 512 * 2;

struct Params { const float* in[26]; float* out; unsigned char* ws; int ph_lo, ph_hi; };

__device__ __forceinline__ float bf2f(unsigned short h) { return __uint_as_float((unsigned)h << 16); }
__device__ __forceinline__ unsigned short f2bf(float f) { unsigned u = __float_as_uint(f); u += 0x7FFFu + ((u >> 16) & 1u); return (unsigned short)(u >> 16); }
__device__ __forceinline__ unsigned cvtpk(float lo, float hi) { unsigned r; asm volatile("v_cvt_pk_bf16_f32 %0, %1, %2" : "=v"(r) : "v"(lo), "v"(hi)); return r; }
__device__ __forceinline__ bf16x8 pack8(f32x4 a, f32x4 b) { u32x4 w = {cvtpk(a[0], a[1]), cvtpk(a[2], a[3]), cvtpk(b[0], b[1]), cvtpk(b[2], b[3])}; return *reinterpret_cast<bf16x8*>(&w); }
__device__ __forceinline__ float sigmoidf_(float x) { return 1.0f / (1.0f + __expf(-x)); }
__device__ __forceinline__ float wave_sum(float v) {
#pragma unroll
    for (int o = 32; o >= 1; o >>= 1) v += __shfl_xor(v, o);
    return v;
}

struct XT { const float* src; int ld; int valid; bf16_t* dst; int dld; int perm; };
__host__ __device__ __forceinline__ int ropedim(int j) { return ((j >> 3) << 2) + (j & 3) + (((j >> 2) & 1) << 6); }
constexpr int XT_WIN = 54 * 16, XT_WOUT = 16 * 16, XT_MOE = 32 * 4 * 16, XT_CW1 = 32, XT_CW2 = 1;
constexpr int XT_TOTAL = XT_WIN + XT_WOUT + 3 * XT_MOE + 2 * XT_CW1 + 2 * XT_CW2;
__device__ __forceinline__ XT xt_decode(const Params& p, int t) {
    XT x; unsigned char* ws = p.ws;
    if (t < XT_WIN) { const int nt = t / 16, kt = t % 16, n0 = nt * 128, k0 = kt * 128;
        const int on = n0 < 2560 ? n0 : (n0 < 6656 ? n0 + 24 : 2560 + (n0 - 6656));
        x.valid = n0 < 6656 ? 128 : (n0 == 6656 ? 24 : 0);
        x.src = p.in[9] + (size_t)k0 * 6680 + (x.valid ? on : 0); x.ld = 6680; x.dst = (bf16_t*)(ws + WS_W1T) + (size_t)n0 * 2048 + k0; x.dld = 2048;
        x.perm = (n0 < 1280 || (n0 >= 1536 && n0 < 1792) || (n0 >= 2048 && n0 < 2304)) ? 1 : 0; return x; }
    t -= XT_WIN;
    if (t < XT_WOUT) { const int nt = t / 16, kt = t % 16, n0 = nt * 128, k0 = kt * 128;
        x.valid = 128; x.src = p.in[10] + (size_t)k0 * 2048 + n0; x.ld = 2048; x.dst = (bf16_t*)(ws + WS_W2T) + (size_t)n0 * 2048 + k0; x.dld = 2048; x.perm = 0; return x; }
    t -= XT_WOUT;
    if (t < 2 * XT_MOE) { const int up = t >= XT_MOE; if (up) t -= XT_MOE; const int e = t / 64, r = t % 64, nt = r / 16, kt = r % 16, n0 = nt * 128, k0 = kt * 128;
        x.valid = 128; x.src = p.in[up ? 24 : 23] + (size_t)e * 2048 * 512 + (size_t)k0 * 512 + n0; x.ld = 512;
        const int drow = e * 1024 + nt * 256 + (up ? 128 : 0);
        x.dst = (bf16_t*)(ws + WS_WGU) + (size_t)drow * 2048 + k0; x.dld = 2048; x.perm = 0; return x; }
    t -= 2 * XT_MOE;
    if (t < XT_MOE) { const int e = t / 64, r = t % 64, nt = r / 4, kt = r % 4, n0 = nt * 128, k0 = kt * 128;
        x.valid = 128; x.src = p.in[25] + (size_t)e * 512 * 2048 + (size_t)k0 * 2048 + n0; x.ld = 2048;
        x.dst = (bf16_t*)(ws + WS_WD) + (size_t)(e * 2048 + n0) * 512 + k0; x.dld = 512; x.perm = 0; return x; }
    t -= XT_MOE;
    if (t < 2 * XT_CW1) { const int kind = t / XT_CW1, kt = t % XT_CW1, k0 = kt * 128;
        x.valid = 128; x.src = p.in[kind ? 15 : 12] + (size_t)k0 * 128; x.ld = 128;
        x.dst = (bf16_t*)(ws + WS_CW1) + (size_t)kind * 128 * 4096 + k0; x.dld = 4096; x.perm = kind ? 0 : 2; return x; }
    t -= 2 * XT_CW1;
    { const int kind = t;
        x.valid = 128; x.src = p.in[kind ? 16 : 13]; x.ld = 128;
        x.dst = (bf16_t*)(ws + WS_CW2) + (size_t)kind * 128 * 128; x.dld = 128; x.perm = kind ? 0 : 1; return x; }
}
constexpr int XT_GU0 = XT_WIN + XT_WOUT, XT_DN0 = XT_GU0 + 2 * XT_MOE, XT_CW0 = XT_DN0 + XT_MOE;
#ifndef MK_GU_TAIL1
#define MK_GU_TAIL1 768
#endif
#ifndef MK_HEAD_PER
#define MK_HEAD_PER 12
#endif
constexpr int XT_GU_TAIL1 = MK_GU_TAIL1;
constexpr int XT_HEAD_PER = MK_HEAD_PER;
#ifdef MK_XFAST
#define XPOSE0 xpose_fast<false>
#define XPOSE1 xpose_fast<true>
#else
#define XPOSE0 xpose_tiles
#define XPOSE1 xpose_tiles
#endif
__device__ __forceinline__ void xpose_tiles(const Params& p, unsigned char* lds, int t_begin, int t_end, int worker, int nworkers, bool ntstore = false) {
    const int tid = threadIdx.x;
    float* tile = (float*)lds;
    const int c4 = (tid & 31) * 4, k4 = tid >> 5;
    f32x4 a[8]; XT x{};
#define XT_LOAD(t_) do { if ((t_) < t_end) { x = xt_decode(p, (t_)); const float* s_ = x.src + (size_t)k4 * x.ld + c4; const bool ok_ = c4 < x.valid; \
        _Pragma("unroll") for (int i = 0; i < 8; ++i) a[i] = ok_ ? NTLD((const f32x4*)(s_ + (size_t)(16 * i) * x.ld)) : (f32x4){0.f, 0.f, 0.f, 0.f}; } } while (0)
    __syncthreads();
    XT_LOAD(t_begin + worker);
    for (int t = t_begin + worker; t < t_end; t += nworkers) {
#pragma unroll
        for (int i = 0; i < 8; ++i) { float* tp = tile + (k4 + 16 * i) * 129 + c4; tp[0] = a[i][0]; tp[1] = a[i][1]; tp[2] = a[i][2]; tp[3] = a[i][3]; }
        bf16_t* dst = x.dst; const int dld = x.dld, perm = x.perm;
        XT_LOAD(t + nworkers);
        __syncthreads();
        { const int nn = tid >> 2, kq = (tid & 3) * 8;
          const int sn = perm == 1 ? ropedim(nn) : nn;
#pragma unroll
          for (int j = 0; j < 4; ++j) { const int kb_ = kq + j * 32; float v[8];
              if (perm == 2) {
#pragma unroll
                  for (int e = 0; e < 8; ++e) v[e] = tile[ropedim(kb_ + e) * 129 + sn];
              } else { const float* tp = tile + kb_ * 129 + sn;
#pragma unroll
                  for (int e = 0; e < 8; ++e) v[e] = tp[e * 129]; }
              u32x4 w; w.x = cvtpk(v[0], v[1]); w.y = cvtpk(v[2], v[3]); w.z = cvtpk(v[4], v[5]); w.w = cvtpk(v[6], v[7]);
              if (ntstore) NTST(w, (u32x4*)(dst + (size_t)nn * dld + kb_)); else *(u32x4*)(dst + (size_t)nn * dld + kb_) = w; } }
        __syncthreads();
    }
#undef XT_LOAD
}
template <bool NT>
__device__ __forceinline__ void xpose_fast(const Params& p, unsigned char* lds, int t_begin, int t_end, int worker, int nworkers) {
    int tid = threadIdx.x; asm volatile("" : "+v"(tid));
    const int l = tid & 31, kk = tid >> 5, rn = tid >> 4, rk = tid & 15;
    const unsigned lb = (unsigned)(uintptr_t)lds;
    const unsigned wbase = lb + (unsigned)(4 * l) * 256u + (unsigned)((kk ^ (l & 15)) << 4);
    f32x4 a0[8], a1[8], a2[8], a3[8];
#define XF_LOAD(A, t_) do { if ((t_) < t_end) { const XT x_ = xt_decode(p, (t_)); const float* sb_ = x_.src + (4 * l < x_.valid ? 4 * l : 0);   \
        _Pragma("unroll") for (int i = 0; i < 8; ++i) { const int kr_ = x_.perm == 2 ? 4 * kk + (i & 3) + 64 * (i >> 2) : 8 * kk + i; const f32x4* s_ = (const f32x4*)(sb_ + (size_t)kr_ * x_.ld); \
            A[i] = NT ? __builtin_nontemporal_load(s_) : *s_; } } } while (0)
#define XF_PROC(A, t_, bo) do { const XT x_ = xt_decode(p, (t_)); \
        _Pragma("unroll") for (int q = 0; q < 4; ++q) { u32x4 w_; w_.x = cvtpk(A[0][q], A[1][q]); w_.y = cvtpk(A[2][q], A[3][q]); w_.z = cvtpk(A[4][q], A[5][q]); w_.w = cvtpk(A[6][q], A[7][q]); \
            *(LAS u32x4*)(uintptr_t)(wbase + (bo) + q * 256) = w_; } \
        XF_LOAD(A, (t_) + 4 * nworkers); \
        __syncthreads(); \
        _Pragma("unroll") for (int j = 0; j < 4; ++j) { const int n_ = rn + 32 * j; const int sn_ = x_.perm == 1 ? ropedim(n_) : n_; \
            u32x4 w_ = *(const LAS u32x4*)(uintptr_t)(lb + (bo) + sn_ * 256 + ((rk ^ ((sn_ >> 2) & 15)) << 4)); if (sn_ >= x_.valid) w_ = (u32x4){0u, 0u, 0u, 0u}; \
            u32x4* d_ = (u32x4*)(x_.dst + (size_t)n_ * x_.dld + rk * 8); \
            if (NT) __builtin_nontemporal_store(w_, d_); else *d_ = w_; } } while (0)
    __syncthreads();
    const int t0 = t_begin + worker;
    XF_LOAD(a0, t0); XF_LOAD(a1, t0 + nworkers); XF_LOAD(a2, t0 + 2 * nworkers); XF_LOAD(a3, t0 + 3 * nworkers);
    for (int t = t0; t < t_end; t += 4 * nworkers) {
        XF_PROC(a0, t, 0u);
        if (t + nworkers < t_end) XF_PROC(a1, t + nworkers, 32768u);
        if (t + 2 * nworkers < t_end) XF_PROC(a2, t + 2 * nworkers, 0u);
        if (t + 3 * nworkers < t_end) XF_PROC(a3, t + 3 * nworkers, 32768u);
    }
    __syncthreads();
#undef XF_LOAD
#undef XF_PROC
}
template <int KIND>
__device__ __forceinline__ void xpose_moe(const Params& p, unsigned char* lds, int worker, int nworkers, int t_begin = 0, int t_end = 1 << 30) {
    constexpr int NTILES = KIND ? XT_MOE : 2 * XT_MOE; constexpr int LD = KIND ? 2048 : 512, DLD = KIND ? 512 : 2048;
    int tid = threadIdx.x; asm volatile("" : "+v"(tid));
    const int l = tid & 31, kk = tid >> 5, rn = tid >> 4, rk = tid & 15;
    const unsigned lb = (unsigned)(uintptr_t)lds;
    const unsigned wbase = lb + (unsigned)(4 * l) * 256u + (unsigned)((kk ^ (l & 15)) << 4);
    const unsigned rb0 = lb + (unsigned)rn * 256u + (unsigned)((rk ^ ((rn >> 2) & 15)) << 4), rb1 = lb + (unsigned)(rn + 32) * 256u + (unsigned)((rk ^ (((rn >> 2) + 8) & 15)) << 4);
    if (t_end > NTILES) t_end = NTILES;
    const int n = t_begin + worker < t_end ? (t_end - t_begin - worker + nworkers - 1) / nworkers : 0;
    __syncthreads();
    if (n > 0) {
        const int tfirst = t_begin + worker, tlast = tfirst + (n - 1) * nworkers;
        const __amdgpu_buffer_rsrc_t rs = __builtin_amdgcn_make_buffer_rsrc((void*)(p.ws + (KIND ? WS_WD : WS_WGU)), 0, NTILES * 128 * 128 * 2, 0x00020000);
        const unsigned loff = (unsigned)(8 * kk) * LD + 4u * l;
        const unsigned soff = ((unsigned)rn * DLD + 8u * rk) * 2u;
        const float* g0 = p.in[23]; const float* g1 = p.in[24]; const float* g2 = p.in[25];
        f32x4 a0[8], a1[8], a2[8], a3[8];
#define XM_T(i_) (min(tfirst + (i_) * nworkers, tlast))
#define XM_LOAD(A, i_) do { const int t_ = XM_T(i_); const float* sb_; \
        if (KIND) { const int e_ = t_ >> 6, r_ = t_ & 63; sb_ = g2 + (size_t)e_ * 1048576 + (size_t)((r_ & 3) * 128) * 2048 + (r_ >> 2) * 128; } \
        else { const int tt_ = t_ & 2047, e_ = tt_ >> 6, r_ = tt_ & 63; sb_ = ((t_ >> 11) ? g1 : g0) + (size_t)e_ * 1048576 + (size_t)((r_ & 15) * 128) * 512 + (r_ >> 4) * 128; } \
        __builtin_amdgcn_sched_barrier(0); _Pragma("unroll") for (int i = 0; i < 8; ++i) A[i] = __builtin_nontemporal_load((const f32x4*)(sb_ + loff + (unsigned)i * LD)); __builtin_amdgcn_sched_barrier(0); } while (0)
#define XM_PROC(A, i_, bo) do { const int t_ = XM_T(i_); unsigned do_; \
        if (KIND) { const int e_ = t_ >> 6, r_ = t_ & 63; do_ = ((unsigned)(e_ * 2048 + (r_ >> 2) * 128) * 512u + (unsigned)(r_ & 3) * 128u) * 2u; } \
        else { const int tt_ = t_ & 2047, e_ = tt_ >> 6, r_ = tt_ & 63; do_ = ((unsigned)(e_ * 1024 + (r_ >> 4) * 256 + (t_ >> 11) * 128) * 2048u + (unsigned)(r_ & 15) * 128u) * 2u; } \
        const unsigned oob_ = (i_) < n ? 0u : 0x80000000u; \
        _Pragma("unroll") for (int q = 0; q < 4; ++q) { u32x4 w_; w_.x = cvtpk(A[0][q], A[1][q]); w_.y = cvtpk(A[2][q], A[3][q]); w_.z = cvtpk(A[4][q], A[5][q]); w_.w = cvtpk(A[6][q], A[7][q]); \
            *(LAS u32x4*)(uintptr_t)(wbase + (bo) + q * 256) = w_; } \
        XM_LOAD(A, (i_) + 4); \
        __syncthreads(); \
        _Pragma("unroll") for (int j = 0; j < 4; ++j) { const u32x4 w_ = *(const LAS u32x4*)(uintptr_t)(((j & 1) ? rb1 : rb0) + (bo) + (j >> 1) * 16384); \
            __builtin_amdgcn_raw_buffer_store_b128(w_, rs, (int)((soff + (unsigned)(32 * j * DLD * 2)) | oob_), (int)do_, 2); } __builtin_amdgcn_sched_barrier(0); } while (0)
        XM_LOAD(a0, 0); XM_LOAD(a1, 1); XM_LOAD(a2, 2); XM_LOAD(a3, 3);
#pragma unroll 1
        for (int i = 0; i < n; i += 4) { XM_PROC(a0, i, 0u); XM_PROC(a1, i + 1, 32768u); XM_PROC(a2, i + 2, 0u); XM_PROC(a3, i + 3, 32768u); }
#undef XM_T
#undef XM_LOAD
#undef XM_PROC
    }
    __syncthreads();
}
__device__ __forceinline__ void p0_prologue(const Params& p, unsigned char* lds) {
    const int tid = threadIdx.x, G = gridDim.x, bx = blockIdx.x;
    unsigned char* ws = p.ws;
#ifndef MK_P0DUP
#define MK_P0DUP 0
#endif
    TC_BEGIN(2);
    for (int rp_ = 0; rp_ < ((MK_P0DUP & 1) ? 2 : 1); ++rp_) if (bx < 192) {
        float* sc = (float*)lds; float* red = (float*)(lds + 32768);
        const float* c = p.in[1];
        for (int i = tid; i < 4 * 2048; i += NTHR) { const float v = c[i]; sc[i] = v / (1.0f + __expf(-v)); }
        __syncthreads();
        const int cg = tid & 15, ks = tid >> 4, col = bx * 64 + cg * 4;
        const float* w = p.in[3] + col;
        f32x4 acc[4] = {};
#pragma unroll 8
        for (int k = ks; k < 2048; k += 32) { const f32x4 wv = NTLD((const f32x4*)(w + (size_t)k * 12288));
#pragma unroll
            for (int b = 0; b < 4; ++b) acc[b] += sc[b * 2048 + k] * wv; }
#pragma unroll
        for (int b = 0; b < 4; ++b) *(f32x4*)&red[(ks * 4 + b) * 64 + cg * 4] = acc[b];
        __syncthreads();
        if (tid < 256) { const int b = tid >> 6, cc = tid & 63; float s = 0.f;
            for (int k2 = 0; k2 < 32; ++k2) s += red[(k2 * 4 + b) * 64 + cc];
            __hip_atomic_store((float*)(ws + WS_MOD) + b * 12288 + bx * 64 + cc, s + p.in[4][bx * 64 + cc], __ATOMIC_RELAXED, __HIP_MEMORY_SCOPE_AGENT); }
        asm volatile("s_waitcnt vmcnt(0)" ::: "memory");
        __syncthreads();
        if (tid == 0) (void)__hip_atomic_fetch_add((unsigned*)(ws + WS_CTL + CTL_MODCNT), 1u, __ATOMIC_RELAXED, __HIP_MEMORY_SCOPE_AGENT);
    }
    TC_END(2, lds); TC_BEGIN(3);
    for (int rp_ = 0; rp_ < ((MK_P0DUP & 2) ? 2 : 1); ++rp_) {
        const int head = (G > 192) ? (G - 192) * XT_HEAD_PER : 0;
#ifdef MK_XMOE
        if (bx >= 192) XPOSE0(p, lds, 0, head, bx - 192, G - 192);
        XPOSE0(p, lds, head, XT_GU0, bx, G);
        xpose_moe<0>(p, lds, bx, G, XT_GU_TAIL1, 2 * XT_MOE);
        XPOSE0(p, lds, XT_CW0, XT_TOTAL, bx, G); }
#else
#pragma unroll 1
        for (int r = (bx >= 192 ? 0 : 1); r < 4; ++r) {
#ifdef MK_GU_P5
            if (r == 2) continue;
#endif
            const int tb = r == 0 ? 0 : (r == 1 ? head : (r == 2 ? XT_GU0 + XT_GU_TAIL1 : XT_CW0)), te = r == 0 ? head : (r == 1 ? XT_GU0 : (r == 2 ? XT_DN0 : XT_TOTAL));
            XPOSE0(p, lds, tb, te, r == 0 ? bx - 192 : bx, r == 0 ? G - 192 : G); } }
#endif
    TC_END(3, lds); TC_BEGIN(4);
    for (int rp_ = 0; rp_ < ((MK_P0DUP & 4) ? 2 : 1); ++rp_) {
        const int* pos = (const int*)p.in[2]; float* ct = (float*)(ws + WS_COS); float* st = (float*)(ws + WS_SIN);
        const float inv = powf(10000.0f, -(float)(tid & 63) / 64.0f);
        for (int i = bx * NTHR + tid; i < T * 64; i += G * NTHR) { const int tok = i >> 6;
            const float ang = (float)pos[tok] * inv; float s, c; sincosf(ang, &s, &c); ct[i] = c; st[i] = s; }
    }
    if (bx == G - 1) { float* lb = (float*)(ws + WS_LB);
        for (int i = tid; i < 1024; i += NTHR) { const float a = p.in[17][i], b = p.in[17][1024 + i]; const float m = fmaxf(a, b); const float ea = expf(a - m), eb = expf(b - m); lb[i] = ea / (ea + eb); } }
    for (int rp_ = 0; rp_ < ((MK_P0DUP & 8) ? 2 : 1); ++rp_) for (int o = bx; o < 256; o += G) { const int kind = o >> 7, n = o & 127; const float* pe = p.in[kind ? 14 : 11]; const float* w1 = p.in[kind ? 15 : 12]; float* red = (float*)lds; float s = 0.f;
#pragma unroll
        for (int k = tid; k < 4096; k += NTHR) s += pe[k] * w1[(size_t)k * 128 + n];
        s = wave_sum(s); __syncthreads(); if ((tid & 63) == 0) red[tid >> 6] = s; __syncthreads();
        if (tid == 0) { float t = 0.f; for (int w = 0; w < 8; ++w) t += red[w]; ((float*)(ws + WS_PEB))[o] = t; } }
    TC_END(4, lds);
}

__device__ __forceinline__ void p1_norm1(const Params& p, unsigned char* lds) {
    const int tid = threadIdx.x, lane = tid & 63, wave = tid >> 6, G = gridDim.x, bx = blockIdx.x;
    unsigned char* ws = p.ws; const float* mod = (const float*)(ws + WS_MOD);
    const float* x = p.in[0]; const float* gpre = p.in[5]; bf16_t* h = (bf16_t*)(ws + WS_R3);
    float* pE = (float*)lds; float* pF = pE + 2048;
    if (tid == 0) { unsigned* mc_ = (unsigned*)(ws + WS_CTL + CTL_MODCNT); unsigned* bar_ = (unsigned*)(ws + WS_CTL);
        XB_SPIN(xb_ld(mc_) < 192u, bar_); }
    __syncthreads();
    for (int gi = bx; gi < T / 64; gi += G) {
        const int b = (gi * 64) >> 12; const float* md = mod + b * 12288;
        __syncthreads();
        for (int i = tid; i < 2048; i += NTHR) { const float m1_ = __hip_atomic_load(md + 2048 + i, __ATOMIC_RELAXED, __HIP_MEMORY_SCOPE_AGENT), m0_ = __hip_atomic_load(md + i, __ATOMIC_RELAXED, __HIP_MEMORY_SCOPE_AGENT);
            pE[i] = gpre[i] * (1.0f + m1_); pF[i] = m0_; }
        __syncthreads();
        const int row0 = gi * 64 + wave * 8;
        f32x4 xa[8], xb[8];
#define P1_LOAD(X, j) do { const float* xr_ = x + (size_t)(row0 + (j)) * DM + lane * 4; _Pragma("unroll") for (int e = 0; e < 8; ++e) X[e] = NTLD((const f32x4*)(xr_ + e * 256)); } while (0)
#define P1_PROC(X, j) do { float ss = 0.f; _Pragma("unroll") for (int e = 0; e < 8; ++e) ss += X[e][0] * X[e][0] + X[e][1] * X[e][1] + X[e][2] * X[e][2] + X[e][3] * X[e][3]; \
        ss = wave_sum(ss); const float r = rsqrtf(ss * (1.0f / DM) + EPS); \
        _Pragma("unroll") for (int e = 0; e < 8; ++e) { const f32x4 ev = *(const f32x4*)(pE + e * 256 + lane * 4), fv = *(const f32x4*)(pF + e * 256 + lane * 4); const f32x4 o = X[e] * r * ev + fv; \
            u32x2 w; w.x = cvtpk(o[0], o[1]); w.y = cvtpk(o[2], o[3]); *(u32x2*)(h + (size_t)(row0 + (j)) * DM + e * 256 + lane * 4) = w; } } while (0)
        P1_LOAD(xa, 0);
#pragma unroll 1
        for (int j = 0; j < 8; j += 2) { P1_LOAD(xb, j + 1); P1_PROC(xa, j); if (j + 2 < 8) P1_LOAD(xa, j + 2); P1_PROC(xb, j + 1); }
#undef P1_LOAD
#undef P1_PROC
    }
    __syncthreads();
}

__device__ __forceinline__ void routing_weights(const Params& p, unsigned char* lds, int worker, int nworkers) {
    const int tid = threadIdx.x, lane = tid & 63, wave = tid >> 6;
    unsigned char* ws = p.ws; const float* mod = (const float*)(ws + WS_MOD);
    float* WR = (float*)(ws + WS_WR); const float* gf = p.in[7]; const float* wg = p.in[19]; const float* wrt = p.in[21];
    for (int i = worker * NTHR + tid; i < 4 * 2048 * 48; i += nworkers * NTHR) { const int n = i % 48, k = (i / 48) & 2047, b = i / (48 * 2048);
        const float a = gf[k] * (1.0f + mod[b * 12288 + 8192 + k]); const float w = n < 4 ? wg[k * 4 + n] : (n < 36 ? wrt[k * 32 + n - 4] : 0.f);
        const float val = a * w; const unsigned short vh = f2bf(val); const unsigned short vl = f2bf(val - bf2f(vh));
        const size_t idx = ((((size_t)b * 64 + (k >> 5)) * 3 + (n >> 4)) * 64 + ((k >> 3) & 3) * 16 + (n & 15)) * 8 + (k & 7);
        ((bf16_t*)WR)[idx] = vh; ((bf16_t*)WR)[393216 + idx] = vl; }
    float* BR = (float*)(ws + WS_BR); float* red = (float*)lds;
#pragma unroll 1
    for (int o = worker; o < 4 * 48; o += nworkers) {
        const int b = o / 48, n = o % 48; float s = 0.f;
        if (n < 36) for (int k = tid; k < 2048; k += NTHR) s += mod[b * 12288 + 6144 + k] * (n < 4 ? wg[k * 4 + n] : wrt[k * 32 + n - 4]);
        s = wave_sum(s); __syncthreads(); if (lane == 0) red[wave] = s; __syncthreads();
        if (tid == 0) { float t = 0.f; for (int w = 0; w < 8; ++w) t += red[w]; BR[o] = n < 4 ? t + p.in[20][n] : (n < 36 ? t + p.in[22][n - 4] : 0.f); } }
    __syncthreads();
}

constexpr float SCALE = 0.08838834764831845f;
constexpr float THR = 8.f;
constexpr int SHM_K = 16384, SHM_V = 16384;
#ifdef MK_SWZ15
#define KSWZ(row, colB) ((row) * 256 + ((colB) ^ (((row) & 15) << 4)))
#else
#define KSWZ(row, colB) ((row) * 256 + ((colB) ^ (((row) & 7) << 4)))
#endif
#define SBAR() __builtin_amdgcn_sched_barrier(0)
__device__ __forceinline__ int v_st(int k, int c) { const int kk = (k & ~0xC) | ((k & 4) << 1) | ((k & 8) >> 1); return ((kk >> 3) * 4 + (c >> 5)) * 512 + ((kk & 7) * 32 + (c & 31)) * 2; }
__device__ __forceinline__ int v_rd_base(int lane) { return ((lane & 3) << 3) | (((lane >> 2) & 3) << 6) | (((lane >> 4) & 1) << 5) | (((lane >> 5) & 1) << 8); }
constexpr int v_rd_off(int d0, int ks, int half) { return d0 * 512 + ks * 4096 + half * 2048; }
__device__ __forceinline__ int crow(int r, int hi) { return (r & 3) + 8 * (r >> 2) + 4 * hi; }
__device__ __forceinline__ void mask_tile(f32x16& p0, f32x16& p1, int dq, unsigned W) {
    const float NEG = -__builtin_inff();
#pragma unroll
    for (int r = 0; r < 16; ++r) {
        const int c = (r & 3) + 8 * (r >> 2);
        if ((unsigned)(dq - c) >= W) p0[r] = NEG;
        if ((unsigned)(dq - c - 32) >= W) p1[r] = NEG;
    }
}
__device__ __forceinline__ void partialSM(f32x16& p0, f32x16& p1, float& m_reg, float& mn, float& alpha, bool rowon = true) {
    float pmax;
    { float m8[8];
#pragma unroll
      for (int r = 0; r < 8; ++r) m8[r] = fmaxf(fmaxf(p0[r], p0[r + 8]), p1[r]);
      const float n0 = fmaxf(fmaxf(m8[0], m8[1]), p1[8]), n1 = fmaxf(fmaxf(m8[2], m8[3]), p1[9]), n2 = fmaxf(fmaxf(m8[4], m8[5]), p1[10]), n3 = fmaxf(fmaxf(m8[6], m8[7]), p1[11]);
      const float q0 = fmaxf(fmaxf(n0, n1), p1[12]), q1 = fmaxf(fmaxf(n2, n3), p1[13]);
      pmax = fmaxf(fmaxf(fmaxf(q0, q1), p1[14]), p1[15]); }
    if (!rowon) pmax = -__builtin_inff();
    { auto rr = __builtin_amdgcn_permlane32_swap(__float_as_uint(pmax), __float_as_uint(pmax), false, false);
      pmax = fmaxf(__uint_as_float(rr[0]), __uint_as_float(rr[1])); }
    constexpr float C2 = 1.4426950408889634f * SCALE;
    if (__builtin_expect(__all((pmax - m_reg) * SCALE <= THR), 1)) { mn = m_reg; alpha = 1.f; }
    else { mn = fmaxf(m_reg, pmax); alpha = __builtin_amdgcn_exp2f((m_reg - mn) * C2); m_reg = mn; }
    const float mnL = rowon ? -mn * C2 : -__builtin_inff();
    { f32x16 c2v, mv;
#pragma unroll
      for (int r = 0; r < 16; ++r) { c2v[r] = C2; mv[r] = mnL; }
      p0 = p0 * c2v + mv; p1 = p1 * c2v + mv; }
    for (int r = 0; r < 16; ++r) p0[r] = __builtin_amdgcn_exp2f(p0[r]);
}
__device__ __forceinline__ void finishSM(f32x16& p0, f32x16& p1, float alpha, float& l_reg, bf16x8& pa0, bf16x8& pa1, bf16x8& pa2, bf16x8& pa3) {
    for (int r = 0; r < 16; ++r) p1[r] = __builtin_amdgcn_exp2f(p1[r]);
    float ps;
    { float s8[8];
#pragma unroll
      for (int r = 0; r < 8; ++r) s8[r] = (p0[r] + p0[r + 8]) + (p1[r] + p1[r + 8]);
      ps = ((s8[0] + s8[1]) + (s8[2] + s8[3])) + ((s8[4] + s8[5]) + (s8[6] + s8[7])); }
    { auto rr = __builtin_amdgcn_permlane32_swap(__float_as_uint(ps), __float_as_uint(ps), false, false);
      ps = __uint_as_float(rr[0]) + __uint_as_float(rr[1]); }
    l_reg = l_reg * alpha + ps;
#define PK4(P, B_, OUT) do { unsigned a0 = cvtpk(P[B_+0], P[B_+1]), a1 = cvtpk(P[B_+2], P[B_+3]);                          \
        unsigned b0 = cvtpk(P[B_+4], P[B_+5]), b1 = cvtpk(P[B_+6], P[B_+7]);                                             \
        auto r0 = __builtin_amdgcn_permlane32_swap(a0, b0, false, false); auto r1 = __builtin_amdgcn_permlane32_swap(a1, b1, false, false); \
        u32x4 w = {r0[0], r1[0], r0[1], r1[1]}; OUT = *reinterpret_cast<bf16x8*>(&w); } while (0)
    PK4(p0, 0, pa0); PK4(p0, 8, pa1); PK4(p1, 0, pa2); PK4(p1, 8, pa3);
#undef PK4
}
template <int KB, bool SK>
__device__ __forceinline__ void qkt(f32x16& p0, f32x16& p1, const char* K_lds, int r32, int hi, const bf16x8* qr, bool act) {
    if (SK && !act) { const float NEG = -__builtin_inff();
#pragma unroll
        for (int r = 0; r < 16; ++r) { p0[r] = NEG; p1[r] = NEG; } return; }
    p0 = f32x16{}; p1 = f32x16{};
    const unsigned kbase = (unsigned)(uintptr_t)K_lds + KB * SHM_K;
    unsigned kb[4];
#pragma unroll
    for (int dd = 0; dd < 4; ++dd) kb[dd] = kbase + KSWZ(r32, (dd * 16 + hi * 8) * 2);
#pragma unroll
    for (int d0 = 0; d0 < 8; ++d0) {
#ifdef MK_SWZ15
        const unsigned a = (d0 < 4) ? kb[d0 & 3] : (kb[d0 & 3] ^ 128u);
#else
        const unsigned a = kb[d0 & 3] + (d0 >> 2) * 128;
#endif
        bf16x8 b0 = *reinterpret_cast<const LAS bf16x8*>((uintptr_t)a);
        bf16x8 b1 = *reinterpret_cast<const LAS bf16x8*>((uintptr_t)(a + 32 * 256));
        p0 = __builtin_amdgcn_mfma_f32_32x32x16_bf16(b0, qr[d0], p0, 0, 0, 0);
        p1 = __builtin_amdgcn_mfma_f32_32x32x16_bf16(b1, qr[d0], p1, 0, 0, 0); }
}
template <int VB, bool SK>
__device__ __forceinline__ void pv_tile(f32x16* o, int vb0, bf16x8 pa0, bf16x8 pa1, bf16x8 pa2, bf16x8 pa3, bool act) {
    if (SK && !act) return;
#define TRRD(dst, off) asm volatile("ds_read_b64_tr_b16 %0, %1 offset:%2" : "=&v"(dst) : "v"(vb0), "i"(off) : "memory")
#define PV_D0(d0) do { s16x4 l0, l1, l2, l3, h0, h1, h2, h3; constexpr int b_ = VB * SHM_V + v_rd_off(d0, 0, 0);     \
        TRRD(l0, b_); TRRD(h0, b_ + 2048); TRRD(l1, b_ + 4096); TRRD(h1, b_ + 6144); TRRD(l2, b_ + 8192); TRRD(h2, b_ + 10240); TRRD(l3, b_ + 12288); TRRD(h3, b_ + 14336); \
        asm volatile("s_waitcnt lgkmcnt(0)" ::: "memory"); SBAR();                 \
        o[d0] = __builtin_amdgcn_mfma_f32_32x32x16_bf16(pa0, (bf16x8){l0[0], l0[1], l0[2], l0[3], h0[0], h0[1], h0[2], h0[3]}, o[d0], 0, 0, 0);   \
        o[d0] = __builtin_amdgcn_mfma_f32_32x32x16_bf16(pa1, (bf16x8){l1[0], l1[1], l1[2], l1[3], h1[0], h1[1], h1[2], h1[3]}, o[d0], 0, 0, 0);   \
        o[d0] = __builtin_amdgcn_mfma_f32_32x32x16_bf16(pa2, (bf16x8){l2[0], l2[1], l2[2], l2[3], h2[0], h2[1], h2[2], h2[3]}, o[d0], 0, 0, 0);   \
        o[d0] = __builtin_amdgcn_mfma_f32_32x32x16_bf16(pa3, (bf16x8){l3[0], l3[1], l3[2], l3[3], h3[0], h3[1], h3[2], h3[3]}, o[d0], 0, 0, 0); } while (0)
    PV_D0(0); PV_D0(1); PV_D0(2); PV_D0(3);
#undef PV_D0
#undef TRRD
}
__device__ __forceinline__ void qkt_rt(f32x16& p0, f32x16& p1, unsigned kbase, int r32, int hi, const bf16x8* qr) {
    p0 = f32x16{}; p1 = f32x16{};
    unsigned kb[4];
#pragma unroll
    for (int dd = 0; dd < 4; ++dd) kb[dd] = kbase + KSWZ(r32, (dd * 16 + hi * 8) * 2);
#ifdef MK_SWZ15
#define QK_ADDR(d0) (((d0) < 4) ? kb[(d0) & 3] : (kb[(d0) & 3] ^ 128u))
#else
#define QK_ADDR(d0) (kb[(d0) & 3] + ((d0) >> 2) * 128)
#endif
#define QK_RD(d0, x0, x1) do { const unsigned a_ = QK_ADDR(d0); asm volatile("ds_read_b128 %0, %1" : "=v"(x0) : "v"(a_) : "memory"); asm volatile("ds_read_b128 %0, %1 offset:8192" : "=v"(x1) : "v"(a_) : "memory"); } while (0)
#define QK_MM(d0, x0, x1, N) do { asm volatile("s_waitcnt lgkmcnt(" #N ")" ::: "memory"); SBAR(); \
        p0 = __builtin_amdgcn_mfma_f32_32x32x16_bf16(x0, qr[d0], p0, 0, 0, 0); p1 = __builtin_amdgcn_mfma_f32_32x32x16_bf16(x1, qr[d0], p1, 0, 0, 0); SBAR(); } while (0)
    bf16x8 a0, a1, b0, b1, c0, c1;
    QK_RD(0, a0, a1); QK_RD(1, b0, b1);
    QK_RD(2, c0, c1); QK_MM(0, a0, a1, 4);
    QK_RD(3, a0, a1); QK_MM(1, b0, b1, 4);
    QK_RD(4, b0, b1); QK_MM(2, c0, c1, 4);
    QK_RD(5, c0, c1); QK_MM(3, a0, a1, 4);
    QK_RD(6, a0, a1); QK_MM(4, b0, b1, 4);
    QK_RD(7, b0, b1); QK_MM(5, c0, c1, 4);
    QK_MM(6, a0, a1, 2);
    QK_MM(7, b0, b1, 0);
#undef QK_MM
#undef QK_RD
#undef QK_ADDR
}
#define TRRD2(lo, hi_, base, off) do { asm volatile("ds_read_b64_tr_b16 %0, %1 offset:%2" : "=&v"(lo) : "v"(base), "i"(off) : "memory"); \
                                        asm volatile("ds_read_b64_tr_b16 %0, %1 offset:%2" : "=&v"(hi_) : "v"(base), "i"((off) + 2048) : "memory"); } while (0)
#define MK8(l, h) ((bf16x8){l[0], l[1], l[2], l[3], h[0], h[1], h[2], h[3]})
#define LGKM0() do { asm volatile("s_waitcnt lgkmcnt(0)" ::: "memory"); SBAR(); } while (0)
__device__ __forceinline__ int lds_addr(const void* p) { return (int)(uintptr_t)p; }

__device__ __forceinline__ void rope_pass(const Params& p, bool dry) {
    bf16_t* proj = (bf16_t*)(p.ws + WS_PROJ); const float* ct = (const float*)(p.ws + WS_COS); const float* st = (const float*)(p.ws + WS_SIN);
    for (int i = blockIdx.x * NTHR + threadIdx.x; i < T * 4 * 8; i += gridDim.x * NTHR) {
        const int ch = i & 7, hd = (i >> 3) & 3, tok = i >> 5;
        const int col = hd < 2 ? COL_KS + hd * 128 : COL_KW + (hd - 2) * 128;
        bf16_t* a = proj + (size_t)tok * LDP + col + ch * 8;
        const bf16x8 t1 = *(const bf16x8*)a, t2 = *(const bf16x8*)(a + 64);
        const f32x4 c0 = *(const f32x4*)(ct + tok * 64 + ch * 8), c1 = *(const f32x4*)(ct + tok * 64 + ch * 8 + 4);
        const f32x4 s0 = *(const f32x4*)(st + tok * 64 + ch * 8), s1 = *(const f32x4*)(st + tok * 64 + ch * 8 + 4);
        float o1[8], o2[8];
#pragma unroll
        for (int j = 0; j < 8; ++j) { const float x1 = bf2f((unsigned short)t1[j]), x2 = bf2f((unsigned short)t2[j]); const float c = j < 4 ? c0[j & 3] : c1[j & 3], s = j < 4 ? s0[j & 3] : s1[j & 3];
            o1[j] = x1 * c - x2 * s; o2[j] = x2 * c + x1 * s; }
        u32x4 w1 = {cvtpk(o1[0], o1[1]), cvtpk(o1[2], o1[3]), cvtpk(o1[4], o1[5]), cvtpk(o1[6], o1[7])};
        u32x4 w2 = {cvtpk(o2[0], o2[1]), cvtpk(o2[2], o2[3]), cvtpk(o2[4], o2[5]), cvtpk(o2[6], o2[7])};
        if (!dry) { *(u32x4*)a = w1; *(u32x4*)(a + 64) = w2; } else if (w1.x == 0x7fc12345u) { *(unsigned*)(p.ws + WS_END) = w2.y; }
    }
}

__device__ __forceinline__ float fexp2(float x) { return __builtin_amdgcn_exp2f(x); }
__device__ __forceinline__ float flog2(float x) { return __builtin_amdgcn_logf(x); }
__device__ __forceinline__ float frcp(float x) { return __builtin_amdgcn_rcpf(x); }
__device__ __forceinline__ float fsigmoid(float x) { return frcp(1.0f + fexp2(-1.4426950408889634f * x)); }
__device__ __forceinline__ float bflo(unsigned w) { return __uint_as_float(w << 16); }
__device__ __forceinline__ float bfhi(unsigned w) { return __uint_as_float(w & 0xffff0000u); }
struct H1Regs { unsigned hfw[8], hqw[8]; bf16x8 v0, v1; };
__device__ __forceinline__ void h1_load(const Params& p, int u, H1Regs& R) {
    const int tid = threadIdx.x, lane = tid & 63, wave = tid >> 6; const int b = u >> 9, h = (u >> 6) & 7, c = u & 63, t0 = b * SEQ + c * 64;
    const bf16_t* proj = (const bf16_t*)(p.ws + WS_PROJ); const bf16_t* rowp = proj + (size_t)(t0 + wave * 8) * LDP + h * 128 + 2 * lane;
#pragma unroll
    for (int j = 0; j < 8; ++j) { R.hfw[j] = *(const unsigned*)(rowp + (size_t)j * LDP + COL_HF); R.hqw[j] = *(const unsigned*)(rowp + (size_t)j * LDP + COL_HQ); }
    const int sr = tid >> 4, sc = (tid & 15) * 8; const bf16_t* vp = proj + (size_t)(t0 + sr) * LDP + COL_HI + h * 128 + sc; R.v0 = *(const bf16x8*)vp; R.v1 = *(const bf16x8*)(vp + (size_t)32 * LDP);
}
__device__ __forceinline__ void hgrn_h1_phase(const Params& p, unsigned char* lds, bool dry) {
    const int tid = threadIdx.x, lane = tid & 63, wave = tid >> 6, r32 = lane & 31, hi = lane >> 5, G = gridDim.x;
    bf16_t* proj = (bf16_t*)(p.ws + WS_PROJ);
    unsigned char* KS = lds; unsigned char* VI = lds + 16384; float* qt = (float*)(lds + 32768);
    unsigned char* SLT = lds + 40960;
    int u = blockIdx.x; if (u >= 2048) return;
    H1Regs R; h1_load(p, u, R);
    for (; u < 2048; u += G) {
    const int b = u >> 9, h = (u >> 6) & 7, c = u & 63, t0 = b * SEQ + c * 64;
    const float* lbp = (const float*)(p.ws + WS_LB) + h * 128 + 2 * lane; const float lb0 = lbp[0], lb1 = lbp[1];
    bf16_t* rowp = proj + (size_t)(t0 + wave * 8) * LDP + h * 128 + 2 * lane;
    float bc0[8], bc1[8], k0[8], k1[8], qs0[8], qs1[8]; float run0 = 0.f, run1 = 0.f;
#pragma unroll
    for (int j = 0; j < 8; ++j) { const float f0 = lb0 + (1.0f - lb0) * fsigmoid(bflo(R.hfw[j])), f1 = lb1 + (1.0f - lb1) * fsigmoid(bfhi(R.hfw[j]));
        run0 += flog2(f0); run1 += flog2(f1); bc0[j] = run0; bc1[j] = run1; k0[j] = 1.0f - f0; k1[j] = 1.0f - f1;
        const float q0 = bflo(R.hqw[j]), q1 = bfhi(R.hqw[j]); qs0[j] = q0 * fsigmoid(q0); qs1[j] = q1 * fsigmoid(q1); }
    *(float2*)(qt + wave * 128 + 2 * lane) = make_float2(run0, run1);
    { const int sr = tid >> 4, sc = (tid & 15) * 8; *(bf16x8*)(VI + v_st(sr, sc)) = R.v0; *(bf16x8*)(VI + v_st(32 + sr, sc)) = R.v1; }
    if (u + G < 2048) h1_load(p, u + G, R);
    __syncthreads();
    float pre0 = 0.f, pre1 = 0.f, mid0 = 0.f, mid1 = 0.f, tot0 = 0.f, tot1 = 0.f;
#pragma unroll
    for (int w = 0; w < 8; ++w) { const float2 q = *(const float2*)(qt + w * 128 + 2 * lane); if (w < wave) { pre0 += q.x; pre1 += q.y; } if (w < 4) { mid0 += q.x; mid1 += q.y; } tot0 += q.x; tot1 += q.y; }
#pragma unroll
    for (int j = 0; j < 8; ++j) { const float c0 = bc0[j] + pre0, c1 = bc1[j] + pre1; const int key = wave * 8 + j;
        *(unsigned*)(KS + v_st(key, 2 * lane)) = cvtpk(k0[j] * fexp2(tot0 - c0), k1[j] * fexp2(tot1 - c1));
        const unsigned wk_ = cvtpk(k0[j] * fexp2(mid0 - c0), k1[j] * fexp2(mid1 - c1)), wq_ = cvtpk(qs0[j] * fexp2(c0 - mid0), qs1[j] * fexp2(c1 - mid1));
        if (!dry) { *(unsigned*)(rowp + (size_t)j * LDP + COL_HF) = wk_; *(unsigned*)(rowp + (size_t)j * LDP + COL_HQ) = wq_; } else if (wk_ == 0x7fc12345u) { *(unsigned*)(p.ws + WS_END) = wq_; } }
    if (wave == 0) { *(float2*)((float*)(p.ws + WS_DECAY) + u * 128 + 2 * lane) = make_float2(fexp2(tot0), fexp2(tot1));
                     *(float2*)((float*)(p.ws + WS_EBM) + u * 128 + 2 * lane) = make_float2(fexp2(mid0), fexp2(mid1)); }
    __syncthreads();
    const int db = wave >> 1; const int ka = lds_addr(KS) + v_rd_base(lane) + db * 512;
    bf16_t* Sl = (bf16_t*)(p.ws + WS_R3) + (size_t)u * 16384;
    s16x4 al[4], ah[4]; TRRD2(al[0], ah[0], ka, 0); TRRD2(al[1], ah[1], ka, 4096); TRRD2(al[2], ah[2], ka, 8192); TRRD2(al[3], ah[3], ka, 12288);
#pragma unroll
    for (int e2 = 0; e2 < 2; ++e2) { const int eb = (wave & 1) * 2 + e2; const int va = lds_addr(VI) + v_rd_base(lane) + eb * 512;
        s16x4 bl[4], bh[4]; TRRD2(bl[0], bh[0], va, 0); TRRD2(bl[1], bh[1], va, 4096); TRRD2(bl[2], bh[2], va, 8192); TRRD2(bl[3], bh[3], va, 12288);
        LGKM0();
        f32x16 acc = {};
#pragma unroll
        for (int ks = 0; ks < 4; ++ks) acc = __builtin_amdgcn_mfma_f32_32x32x16_bf16(MK8(al[ks], ah[ks]), MK8(bl[ks], bh[ks]), acc, 0, 0, 0);
#pragma unroll
        for (int r = 0; r < 16; ++r) *(bf16_t*)(SLT + (db * 32 + crow(r, hi)) * 256 + (eb * 32 + r32) * 2) = f2bf(acc[r]); }
    __syncthreads();
#pragma unroll
    for (int k = 0; k < 4; ++k) *(u32x4*)((unsigned char*)Sl + (tid + 512 * k) * 16) = *(const u32x4*)(SLT + (tid + 512 * k) * 16);
    __syncthreads();
    }
}
__device__ __forceinline__ void hgrn_h2_scan(const Params& p, int worker, int nworkers) {
    const bf16_t* Sl = (const bf16_t*)(p.ws + WS_R3); bf16_t* St = (bf16_t*)(p.ws + WS_R4); const float* decay = (const float*)(p.ws + WS_DECAY); const float* ebm = (const float*)(p.ws + WS_EBM);
    const int stride = nworkers * NTHR;
    for (int i = worker * NTHR + threadIdx.x; i < 32 * 4096; i += 2 * stride) {
        const int j = i + stride; const bool two = j < 32 * 4096; const int jj = two ? j : i;
        const int bh = i >> 12, e4 = (i & 4095) * 4, d = e4 >> 7; float s0 = 0.f, s1 = 0.f, s2 = 0.f, s3 = 0.f;
        const int bh2 = jj >> 12, f4 = (jj & 4095) * 4, d2 = f4 >> 7; float t0 = 0.f, t1 = 0.f, t2 = 0.f, t3 = 0.f;
#pragma unroll 8
        for (int c = 0; c < 64; ++c) { const size_t u = (size_t)bh * 64 + c, u2 = (size_t)bh2 * 64 + c;
            const u32x2 sl = NTLD((const u32x2*)(Sl + u * 16384 + e4)); const float dc = decay[u * 128 + d], em = ebm[u * 128 + d];
            const u32x2 tl = NTLD((const u32x2*)(Sl + u2 * 16384 + f4)); const float dc2 = decay[u2 * 128 + d2], em2 = ebm[u2 * 128 + d2];
            u32x2 w; w.x = cvtpk(s0 * em, s1 * em); w.y = cvtpk(s2 * em, s3 * em); *(u32x2*)(St + u * 16384 + e4) = w;
            s0 = dc * s0 + __uint_as_float(sl.x << 16); s1 = dc * s1 + __uint_as_float(sl.x & 0xffff0000u); s2 = dc * s2 + __uint_as_float(sl.y << 16); s3 = dc * s3 + __uint_as_float(sl.y & 0xffff0000u);
            if (two) { u32x2 w2; w2.x = cvtpk(t0 * em2, t1 * em2); w2.y = cvtpk(t2 * em2, t3 * em2); *(u32x2*)(St + u2 * 16384 + f4) = w2; }
            t0 = dc2 * t0 + __uint_as_float(tl.x << 16); t1 = dc2 * t1 + __uint_as_float(tl.x & 0xffff0000u); t2 = dc2 * t2 + __uint_as_float(tl.y << 16); t3 = dc2 * t3 + __uint_as_float(tl.y & 0xffff0000u); }
    }
}
#define PK4(P, B_, OUT) do { unsigned a0 = cvtpk(P[B_+0], P[B_+1]), a1 = cvtpk(P[B_+2], P[B_+3]);                          \
        unsigned b0 = cvtpk(P[B_+4], P[B_+5]), b1 = cvtpk(P[B_+6], P[B_+7]);                                             \
        auto r0 = __builtin_amdgcn_permlane32_swap(a0, b0, false, false); auto r1 = __builtin_amdgcn_permlane32_swap(a1, b1, false, false); \
        u32x4 w = {r0[0], r1[0], r0[1], r1[1]}; OUT = *reinterpret_cast<bf16x8*>(&w); } while (0)
struct H3Regs { bf16x8 q0, q1, k0, k1, v0, v1, s0, s1, s2, s3, g0, g1; };
__device__ __forceinline__ void h3_load(const Params& p, int u, H3Regs& R, int tid) {
    const int sr = tid >> 4, sc = (tid & 15) * 8; const int b = u >> 9, h = (u >> 6) & 7, c = u & 63, t0 = b * SEQ + c * 64;
    const bf16_t* rp = (const bf16_t*)(p.ws + WS_PROJ) + (size_t)(t0 + sr) * LDP + h * 128 + sc; const size_t o32 = (size_t)32 * LDP;
    R.q0 = *(const bf16x8*)(rp + COL_HQ); R.q1 = *(const bf16x8*)(rp + COL_HQ + o32); R.k0 = *(const bf16x8*)(rp + COL_HF); R.k1 = *(const bf16x8*)(rp + COL_HF + o32);
    R.v0 = *(const bf16x8*)(rp + COL_HI); R.v1 = *(const bf16x8*)(rp + COL_HI + o32); R.g0 = *(const bf16x8*)(rp + COL_HG); R.g1 = *(const bf16x8*)(rp + COL_HG + o32);
    const bf16_t* sp = (const bf16_t*)(p.ws + WS_R4) + (size_t)u * 16384 + sr * 128 + sc;
    R.s0 = *(const bf16x8*)sp; R.s1 = *(const bf16x8*)(sp + 32 * 128); R.s2 = *(const bf16x8*)(sp + 64 * 128); R.s3 = *(const bf16x8*)(sp + 96 * 128);
}
__device__ __forceinline__ void hgrn_h3_phase(const Params& p, unsigned char* lds) {
    int tid = threadIdx.x; asm volatile("" : "+v"(tid));
    const int lane = tid & 63, wave = tid >> 6, r32 = lane & 31, hi = lane >> 5, G = gridDim.x;
    unsigned char* QT = lds; unsigned char* KT = lds + 16384; unsigned char* VI = lds + 32768; unsigned char* STI = lds + 49152; unsigned char* HG = lds + 81920;
    float* part = (float*)(lds + 98304);
    const int sr = tid >> 4, sc = (tid & 15) * 8;
    int u = blockIdx.x; if (u >= 2048) return;
    H3Regs R; h3_load(p, u, R, tid);
    for (; u < 2048; u += G) {
        const int b = u >> 9, h = (u >> 6) & 7, c = u & 63, t0 = b * SEQ + c * 64;
        *(bf16x8*)(QT + KSWZ(sr, sc * 2)) = R.q0; *(bf16x8*)(QT + KSWZ(32 + sr, sc * 2)) = R.q1; *(bf16x8*)(KT + KSWZ(sr, sc * 2)) = R.k0; *(bf16x8*)(KT + KSWZ(32 + sr, sc * 2)) = R.k1;
        *(bf16x8*)(VI + v_st(sr, sc)) = R.v0; *(bf16x8*)(VI + v_st(32 + sr, sc)) = R.v1;
        *(bf16x8*)(STI + v_st(sr, sc)) = R.s0; *(bf16x8*)(STI + v_st(32 + sr, sc)) = R.s1; *(bf16x8*)(STI + 16384 + v_st(sr, sc)) = R.s2; *(bf16x8*)(STI + 16384 + v_st(32 + sr, sc)) = R.s3;
        *(bf16x8*)(HG + sr * 256 + sc * 2) = R.g0; *(bf16x8*)(HG + (32 + sr) * 256 + sc * 2) = R.g1;
        if (u + G < 2048) h3_load(p, u + G, R, tid);
        __syncthreads();
        const int ib = wave >> 2, eb = wave & 3, irow = ib * 32 + r32;
        bf16x8 qf8[8];
#pragma unroll
        for (int d0 = 0; d0 < 8; ++d0) qf8[d0] = *(const bf16x8*)(QT + KSWZ(irow, (d0 * 16 + hi * 8) * 2));
        f32x16 p0, p1; qkt_rt(p0, p1, (unsigned)lds_addr(KT), r32, hi, qf8);
#pragma unroll
        for (int r = 0; r < 16; ++r) { const int j = crow(r, hi); if (j > irow) p0[r] = 0.f; if (j + 32 > irow) p1[r] = 0.f; }
        bf16x8 pa0, pa1, pa2, pa3; PK4(p0, 0, pa0); PK4(p0, 8, pa1); PK4(p1, 0, pa2); PK4(p1, 8, pa3);
        f32x16 o = {};
        { const int va = lds_addr(VI) + v_rd_base(lane) + eb * 512; s16x4 l0, h0, l1, h1, l2, h2, l3, h3;
          TRRD2(l0, h0, va, 0); TRRD2(l1, h1, va, 4096); TRRD2(l2, h2, va, 8192); TRRD2(l3, h3, va, 12288); LGKM0();
          o = __builtin_amdgcn_mfma_f32_32x32x16_bf16(pa0, MK8(l0, h0), o, 0, 0, 0); o = __builtin_amdgcn_mfma_f32_32x32x16_bf16(pa1, MK8(l1, h1), o, 0, 0, 0);
          o = __builtin_amdgcn_mfma_f32_32x32x16_bf16(pa2, MK8(l2, h2), o, 0, 0, 0); o = __builtin_amdgcn_mfma_f32_32x32x16_bf16(pa3, MK8(l3, h3), o, 0, 0, 0); }
        { const int sa = lds_addr(STI) + v_rd_base(lane) + eb * 512; s16x4 l0, h0, l1, h1, l2, h2, l3, h3;
          TRRD2(l0, h0, sa, 0); TRRD2(l1, h1, sa, 4096); TRRD2(l2, h2, sa, 8192); TRRD2(l3, h3, sa, 12288); LGKM0();
          o = __builtin_amdgcn_mfma_f32_32x32x16_bf16(qf8[0], MK8(l0, h0), o, 0, 0, 0); o = __builtin_amdgcn_mfma_f32_32x32x16_bf16(qf8[1], MK8(l1, h1), o, 0, 0, 0);
          o = __builtin_amdgcn_mfma_f32_32x32x16_bf16(qf8[2], MK8(l2, h2), o, 0, 0, 0); o = __builtin_amdgcn_mfma_f32_32x32x16_bf16(qf8[3], MK8(l3, h3), o, 0, 0, 0);
          TRRD2(l0, h0, sa, 16384); TRRD2(l1, h1, sa, 16384 + 4096); TRRD2(l2, h2, sa, 16384 + 8192); TRRD2(l3, h3, sa, 16384 + 12288); LGKM0();
          o = __builtin_amdgcn_mfma_f32_32x32x16_bf16(qf8[4], MK8(l0, h0), o, 0, 0, 0); o = __builtin_amdgcn_mfma_f32_32x32x16_bf16(qf8[5], MK8(l1, h1), o, 0, 0, 0);
          o = __builtin_amdgcn_mfma_f32_32x32x16_bf16(qf8[6], MK8(l2, h2), o, 0, 0, 0); o = __builtin_amdgcn_mfma_f32_32x32x16_bf16(qf8[7], MK8(l3, h3), o, 0, 0, 0); }
        __syncthreads();
        { float* OT = (float*)lds;
#pragma unroll
          for (int r = 0; r < 16; ++r) OT[(ib * 32 + crow(r, hi)) * 128 + eb * 32 + r32] = o[r]; }
        __syncthreads();
        { const int row = tid >> 3, seg = tid & 7; const float* orow = (const float*)lds + row * 128 + seg * 16;
          const f32x4 v0 = *(const f32x4*)orow, v1 = *(const f32x4*)(orow + 4), v2 = *(const f32x4*)(orow + 8), v3 = *(const f32x4*)(orow + 12);
          float ss = (v0[0] * v0[0] + v0[1] * v0[1] + v0[2] * v0[2] + v0[3] * v0[3]) + (v1[0] * v1[0] + v1[1] * v1[1] + v1[2] * v1[2] + v1[3] * v1[3])
                   + (v2[0] * v2[0] + v2[1] * v2[1] + v2[2] * v2[2] + v2[3] * v2[3]) + (v3[0] * v3[0] + v3[1] * v3[1] + v3[2] * v3[2] + v3[3] * v3[3]);
          ss += __shfl_xor(ss, 1); ss += __shfl_xor(ss, 2); ss += __shfl_xor(ss, 4);
          const float rn = __builtin_amdgcn_rsqf(ss * (1.0f / 128.0f) + EPS);
          const float* gnp = p.in[18] + h * 128 + seg * 16; const f32x4 g0 = *(const f32x4*)gnp, g1 = *(const f32x4*)(gnp + 4), g2 = *(const f32x4*)(gnp + 8), g3 = *(const f32x4*)(gnp + 12);
          const bf16x8 ha = *(const bf16x8*)(HG + row * 256 + seg * 32), hb = *(const bf16x8*)(HG + row * 256 + seg * 32 + 16);
          float ov[16];
#pragma unroll
          for (int j = 0; j < 4; ++j) { const float ga = bf2f((unsigned short)ha[j]), gb = bf2f((unsigned short)ha[4 + j]), gc = bf2f((unsigned short)hb[j]), gd = bf2f((unsigned short)hb[4 + j]);
              ov[j] = v0[j] * rn * g0[j] * ga * fsigmoid(ga); ov[4 + j] = v1[j] * rn * g1[j] * gb * fsigmoid(gb); ov[8 + j] = v2[j] * rn * g2[j] * gc * fsigmoid(gc); ov[12 + j] = v3[j] * rn * g3[j] * gd * fsigmoid(gd); }
          bf16_t* oc = (bf16_t*)(p.ws + WS_R3) + (size_t)(t0 + row) * 2048 + 1024 + h * 128 + seg * 16;
          *(u32x4*)oc = (u32x4){cvtpk(ov[0], ov[1]), cvtpk(ov[2], ov[3]), cvtpk(ov[4], ov[5]), cvtpk(ov[6], ov[7])};
          *(u32x4*)(oc + 8) = (u32x4){cvtpk(ov[8], ov[9]), cvtpk(ov[10], ov[11]), cvtpk(ov[12], ov[13]), cvtpk(ov[14], ov[15])}; }
        __syncthreads();
    }
}

__device__ __forceinline__ void compress_unit(const Params& p, unsigned char* lds, int u) {
    const int tid = threadIdx.x, lane = tid & 63, wave = tid >> 6, fr = lane & 15, fq = lane >> 4;
    const int kind = u >> 6, b = (u >> 4) & 3, g = (u >> 3) & 1, ct = u & 7;
    const bf16_t* proj = (const bf16_t*)(p.ws + WS_PROJ) + (size_t)b * SEQ * LDP + (kind ? COL_VC : COL_KC) + g * 128;
    const bf16_t* w1 = (const bf16_t*)(p.ws + WS_CW1) + (size_t)kind * 128 * 4096 + (size_t)(wave * 16 + fr) * 4096 + fq * 8;
    const bf16_t* w2 = (const bf16_t*)(p.ws + WS_CW2) + (size_t)kind * 128 * 128 + (size_t)(wave * 16 + fr) * 128 + fq * 8;
    constexpr int NR = 528;
    unsigned char* At = lds;
    bf16_t* hid = (bf16_t*)lds;
    { bf16x8 st[17];
#pragma unroll
      for (int j = 0; j < 17; ++j) { const int i = tid + j * NTHR; const int r = i >> 4, ch = i & 15; int tk = ct * 512 + r; tk = tk < SEQ ? tk : SEQ - 1; st[j] = *(const bf16x8*)(proj + (size_t)tk * LDP + ch * 8); }
#pragma unroll
      for (int j = 0; j < 17; ++j) { const int i = tid + j * NTHR; const int r = i >> 4, ch = i & 15; if (i < NR * 16) *(bf16x8*)(At + r * 256 + ((ch ^ ((r >> 4) & 15)) << 4)) = st[j]; } }
    __syncthreads();
    f32x4 a0 = {}, a1 = {};
    bf16x8 Ba[4], Bb[4], Bc[4], Bd[4], Be[4];
#define CU_LDB(dst, l_) do { const bf16_t* wr_ = w1 + (l_) * 128; dst[0] = *(const bf16x8*)wr_; dst[1] = *(const bf16x8*)(wr_ + 32); dst[2] = *(const bf16x8*)(wr_ + 64); dst[3] = *(const bf16x8*)(wr_ + 96); } while (0)
#define CU_STEP(l_, Bx) do { const int r0 = 16 * fr + (l_), r1 = r0 + 256; const unsigned char* ar0 = At + r0 * 256; const unsigned char* ar1 = At + r1 * 256; const int sw = (r0 >> 4) & 15; \
        _Pragma("unroll") for (int s = 0; s < 4; ++s) { const int co = ((4 * s + fq) ^ sw) << 4; \
            a0 = __builtin_amdgcn_mfma_f32_16x16x32_bf16(*(const bf16x8*)(ar0 + co), Bx[s], a0, 0, 0, 0); a1 = __builtin_amdgcn_mfma_f32_16x16x32_bf16(*(const bf16x8*)(ar1 + co), Bx[s], a1, 0, 0, 0); } } while (0)
    CU_LDB(Ba, 0); CU_LDB(Bb, 1); CU_LDB(Bc, 2); CU_LDB(Bd, 3);
#pragma unroll 1
    for (int l = 0; l < 30; l += 5) {
        CU_LDB(Be, l + 4); CU_STEP(l, Ba);
        CU_LDB(Ba, l + 5); CU_STEP(l + 1, Bb);
        CU_LDB(Bb, l + 6); CU_STEP(l + 2, Bc);
        CU_LDB(Bc, l + 7); CU_STEP(l + 3, Bd);
        CU_LDB(Bd, l + 8); CU_STEP(l + 4, Be);
    }
    CU_STEP(30, Ba); CU_STEP(31, Bb);
#undef CU_LDB
#undef CU_STEP
    const float pb = ((const float*)(p.ws + WS_PEB))[kind * 128 + wave * 16 + fr];
    __syncthreads();
#pragma unroll
    for (int r = 0; r < 4; ++r) { float v0 = a0[r] + pb, v1 = a1[r] + pb; v0 = v0 * sigmoidf_(v0); v1 = v1 * sigmoidf_(v1);
        hid[(fq * 4 + r) * 136 + wave * 16 + fr] = f2bf(v0); hid[(16 + fq * 4 + r) * 136 + wave * 16 + fr] = f2bf(v1); }
    __syncthreads();
    f32x4 o0 = {}, o1 = {};
#pragma unroll
    for (int s = 0; s < 4; ++s) { const bf16x8 A0 = *(const bf16x8*)(hid + fr * 136 + s * 32 + fq * 8), A1 = *(const bf16x8*)(hid + (16 + fr) * 136 + s * 32 + fq * 8), Bf = *(const bf16x8*)(w2 + s * 32);
        o0 = __builtin_amdgcn_mfma_f32_16x16x32_bf16(A0, Bf, o0, 0, 0, 0); o1 = __builtin_amdgcn_mfma_f32_16x16x32_bf16(A1, Bf, o1, 0, 0, 0); }
    bf16_t* dst = (bf16_t*)(p.ws + (kind ? WS_VC : WS_KC)) + (size_t)((b * 2 + g) * 256) * 128 + wave * 16 + fr;
#pragma unroll
    for (int r = 0; r < 4; ++r) { const int ra = ct * 32 + fq * 4 + r, rb = ra + 16;
        dst[(size_t)ra * 128] = ra < 255 ? f2bf(o0[r]) : (bf16_t)0; dst[(size_t)rb * 128] = rb < 255 ? f2bf(o1[r]) : (bf16_t)0; }
    __syncthreads();
}
constexpr int AT_K = 3 * 16384, AT_WS = 81920, AT_SEL = 83968, AT_IMP = 86016, IMP_LD = 65;
template <int MODE>
__device__ __forceinline__ void attn_sweep(unsigned char* lds, const bf16_t* Kg, const bf16_t* Vg, int ld, int t_lo, int t_hi, const bf16x8 (&qr)[8],
                                           int tq, int qlo, unsigned long long selm, int qb, f32x16 (&o)[4], float& m_reg, float& l_reg) {
    const int tid = threadIdx.x, wid = __builtin_amdgcn_readfirstlane(tid >> 6), lane = tid & 63, r32 = lane & 31, hi = lane >> 5;
    const int sr = tid >> 4, sc = (tid & 15) * 8, vst0 = v_st(sr, sc), vst1 = v_st(32 + sr, sc), kws = KSWZ(sr, sc * 2);
    char* V_lds = (char*)lds; char* K_lds = (char*)lds + AT_K; LAS float* al_l = (LAS float*)(uintptr_t)(lds_addr(lds) + AT_WS + wid * 256);
    const int vb0 = lds_addr(V_lds) + v_rd_base(lane);
    bf16x8 st_k0, st_k1, st_v0, st_v1;
    if (t_lo >= t_hi) return;
#define AT_LOAD(t) do { const bf16_t* kp = Kg + (size_t)((t) * 64 + sr) * ld + sc; const bf16_t* vp = Vg + (size_t)((t) * 64 + sr) * ld + sc; \
        st_k0 = *(const bf16x8*)kp; st_k1 = *(const bf16x8*)(kp + (size_t)32 * ld); st_v0 = *(const bf16x8*)vp; st_v1 = *(const bf16x8*)(vp + (size_t)32 * ld); } while (0)
#define AT_WRITE(bf) do { *(bf16x8*)(K_lds + (bf) * SHM_K + kws) = st_k0; *(bf16x8*)(K_lds + (bf) * SHM_K + kws + 32 * 256) = st_k1; \
        *(bf16x8*)(V_lds + (bf) * SHM_V + vst0) = st_v0; *(bf16x8*)(V_lds + (bf) * SHM_V + vst1) = st_v1; } while (0)
#define AT_RESC(a) do { if (__any((a) < 1.f)) { if (hi == 0) al_l[r32] = (a); asm volatile("s_waitcnt lgkmcnt(0)" ::: "memory"); \
        _Pragma("unroll") for (int d_ = 0; d_ < 4; ++d_) _Pragma("unroll") for (int r = 0; r < 16; ++r) o[d_][r] *= al_l[crow(r, hi)]; } } while (0)
#define AT_STEP(t, BUF) do { const bool more_ = (t) + 1 < t_hi; if (more_) AT_LOAD((t) + 1); \
        const int kb_ = (t) * 64; bool act_ = true; bool on_ = true; \
        if (MODE == 1) { const unsigned sw_ = ((const LAS unsigned*)(uintptr_t)(lds_addr(lds) + AT_SEL))[(tq & 63) * 2 + ((t) >> 5)]; on_ = ((sw_ >> ((t) & 31)) & 1u) != 0u; act_ = __any(on_); } \
        if (act_) { f32x16 p0, p1; qkt<BUF, false>(p0, p1, K_lds, r32, hi, qr, true); \
            if (MODE == 2) { if (kb_ + 63 > qlo || kb_ <= qlo + 31 - 512) mask_tile(p0, p1, tq - 4 * hi - kb_, 512u); } \
            if (MODE == 1) { if ((t) == qb) mask_tile(p0, p1, tq - 4 * hi - kb_, 1u << 30); \
                if (!on_) { const float NEG_ = -__builtin_inff(); _Pragma("unroll") for (int r = 0; r < 16; ++r) { p0[r] = NEG_; p1[r] = NEG_; } } } \
            if (MODE == 0) { mask_tile(p0, p1, ((tq - 31) >> 4) - 4 * hi - kb_, 1u << 30); } \
            float mn_, alpha_; partialSM(p0, p1, m_reg, mn_, alpha_); AT_RESC(alpha_); \
            bf16x8 pa0, pa1, pa2, pa3; finishSM(p0, p1, alpha_, l_reg, pa0, pa1, pa2, pa3); SBAR(); \
            pv_tile<BUF, false>(o, vb0, pa0, pa1, pa2, pa3, true); } \
        if (more_) AT_WRITE((BUF) ^ 1); \
        __syncthreads(); } while (0)
    __syncthreads();
    AT_LOAD(t_lo); AT_WRITE(0); __syncthreads();
    for (int t = t_lo; t < t_hi; t += 2) {
        AT_STEP(t, 0);
        if (t + 1 < t_hi) AT_STEP(t + 1, 1);
    }
#undef AT_LOAD
#undef AT_WRITE
#undef AT_RESC
#undef AT_STEP
}

template <int MODE>
__device__ __forceinline__ void attn_sweep4(unsigned char* lds, const bf16_t* Kg, const bf16_t* Vg, int ld, int t_lo, int t_hi, const bf16x8 (&qr)[8],
                                            int tq, int qlo, unsigned long long selm, int qb, f32x16 (&o)[4], float& m_reg, float& l_reg, int var = 0, float* ir = nullptr, float* mt = nullptr) {
    (void)selm;
    int tid = threadIdx.x; asm volatile("" : "+v"(tid));
    const int wid = __builtin_amdgcn_readfirstlane(tid >> 6), lane = tid & 63, r32 = lane & 31, hi = lane >> 5;
    const unsigned lbase = (unsigned)lds_addr(lds);
    LAS float* al_l = (LAS float*)(uintptr_t)(lbase + AT_WS + wid * 256);
    const int vb0 = (int)lbase + v_rd_base(lane);
    const int NT = t_hi - t_lo; if (NT <= 0) return;
    int ko[2], vo[2];
#pragma unroll
    for (int j = 0; j < 2; ++j) { const int pz = j * 512 + tid; const int row = pz >> 4, ch = (pz & 15) ^ (row & 15); ko[j] = row * ld + ch * 8;
        const int kk = (pz >> 7) * 8 + ((pz & 31) >> 2), k = (kk & ~0xC) | ((kk & 4) << 1) | ((kk & 8) >> 1), c0 = ((pz >> 5) & 3) * 32 + (pz & 3) * 8; vo[j] = k * ld + c0; }
#define S3_DMA(i, kbo, vbo) do { const bf16_t* kt_ = Kg + (size_t)((t_lo + (i)) * 64) * ld; const bf16_t* vt_ = Vg + (size_t)((t_lo + (i)) * 64) * ld; \
        _Pragma("unroll") for (int j = 0; j < 2; ++j) { \
            __builtin_amdgcn_global_load_lds((const unsigned*)(kt_ + ko[j]), (LAS unsigned*)(uintptr_t)(lbase + AT_K + (kbo) + j * 8192 + wid * 1024), 16, 0, 0); \
            __builtin_amdgcn_global_load_lds((const unsigned*)(vt_ + vo[j]), (LAS unsigned*)(uintptr_t)(lbase + (vbo) + j * 8192 + wid * 1024), 16, 0, 0); } } while (0)
    __syncthreads();
    S3_DMA(0, 0u, 0);
    asm volatile("s_waitcnt vmcnt(0)" ::: "memory");
    __syncthreads();
    const bool setB = wid >= 4;
    if (setB) { if (NT > 1) S3_DMA(1, 16384u, 16384); __builtin_amdgcn_s_barrier(); }
    bf16x8 pa0 = {}, pa1 = {}, pa2 = {}, pa3 = {}; bool prev_act = false;
    int vprev = 0, vcur = 0, vnext = 16384;
    float carry_ = 0.f, mprev_ = 0.f;
    for (int i = 0; i < NT; ++i) {
        const int t = t_lo + i, kb_ = t * 64; const unsigned kcur = (unsigned)(i & 1) * 16384u;
        if (!setB && i + 1 < NT) S3_DMA(i + 1, (unsigned)((i + 1) & 1) * 16384u, vnext);
        bool act_ = true, on_ = true;
        if (MODE == 1) { const unsigned sw_ = ((const LAS unsigned*)(uintptr_t)(lbase + AT_SEL))[(tq & 63) * 2 + (t >> 5)]; on_ = ((sw_ >> (t & 31)) & 1u) != 0u; act_ = __any(on_); }
        f32x16 p0, p1;
        if (act_) { if (!(var & 1)) qkt_rt(p0, p1, lbase + AT_K + kcur, r32, hi, qr); else { p0 = f32x16{}; p1 = f32x16{}; } }
        if (prev_act && !(var & 2)) pv_tile<0, false>(o, vb0 + vprev, pa0, pa1, pa2, pa3, true);
        if (setB) asm volatile("s_waitcnt vmcnt(0)" ::: "memory");
        __builtin_amdgcn_s_barrier();
        if (setB && i + 2 < NT) S3_DMA(i + 2, kcur, vnext == 32768 ? 0 : vnext + 16384);
        if (act_ && !(var & 4)) {
            if (MODE == 2) { if (kb_ + 63 > qlo || kb_ <= qlo + 31 - 512) mask_tile(p0, p1, tq - 4 * hi - kb_, 512u); }
            if (MODE == 1) { if (t == qb) mask_tile(p0, p1, tq - 4 * hi - kb_, 1u << 30);
                if (!on_) { const float NEG_ = -__builtin_inff();
#pragma unroll
                    for (int r = 0; r < 16; ++r) { p0[r] = NEG_; p1[r] = NEG_; } } }
            if (MODE == 0) { mask_tile(p0, p1, ((tq - 31) >> 4) - 4 * hi - kb_, 1u << 30); }
            float mn_, alpha_; partialSM(p0, p1, m_reg, mn_, alpha_);
            if (__any(alpha_ < 1.f)) { if (hi == 0) al_l[r32] = alpha_; asm volatile("s_waitcnt lgkmcnt(0)" ::: "memory");
#pragma unroll
                for (int d_ = 0; d_ < 4; ++d_)
#pragma unroll
                    for (int r = 0; r < 16; ++r) o[d_][r] *= al_l[crow(r, hi)]; }
            finishSM(p0, p1, alpha_, l_reg, pa0, pa1, pa2, pa3);
            if (MODE == 0 && ir != nullptr) {
                constexpr float C2i = 1.4426950408889634f * SCALE;
                float s4[8], lastv[8];
#pragma unroll
                for (int g4 = 0; g4 < 4; ++g4) { s4[g4] = (p0[4 * g4] + p0[4 * g4 + 1]) + (p0[4 * g4 + 2] + p0[4 * g4 + 3]); lastv[g4] = p0[4 * g4 + 3];
                    s4[4 + g4] = (p1[4 * g4] + p1[4 * g4 + 1]) + (p1[4 * g4 + 2] + p1[4 * g4 + 3]); lastv[4 + g4] = p1[4 * g4 + 3]; }
                const float cin = carry_ > 0.f ? carry_ * __builtin_amdgcn_exp2f((mprev_ - mn_) * C2i) : 0.f;
#pragma unroll
                for (int gi = 0; gi < 8; ++gi) { const float snd = hi ? (gi > 0 ? lastv[gi - 1] : cin) : lastv[gi]; const float rcv = __shfl_xor(snd, 32);
                    ir[16 * i + 2 * gi + hi] = s4[gi] + rcv; }
                carry_ = lastv[7]; mprev_ = mn_;
                if (i == 0) mt[0] = mn_; else if (i == 1) mt[1] = mn_; else if (i == 2) mt[2] = mn_; else mt[3] = mn_;
            }
        }
        prev_act = act_;
        vprev = vcur; vcur = vnext; vnext = vnext == 32768 ? 0 : vnext + 16384;
        if (!setB) asm volatile("s_waitcnt vmcnt(0)" ::: "memory");
        __builtin_amdgcn_s_barrier();
    }
    if (prev_act) pv_tile<0, false>(o, vb0 + vprev, pa0, pa1, pa2, pa3, true);
    if (!setB) __builtin_amdgcn_s_barrier();
#undef S3_DMA
}

template <int MODE>
__device__ __forceinline__ void attn_sweep3(unsigned char* lds, const bf16_t* Kg, const bf16_t* Vg, int ld, int t_lo, int t_hi, const bf16x8 (&qr)[8],
                                            int tq, int qlo, unsigned long long selm, int qb, f32x16 (&o)[4], float& m_reg, float& l_reg, int var = 0, float* ir = nullptr, float* mt = nullptr) {
    (void)selm;
    int tid = threadIdx.x; asm volatile("" : "+v"(tid));
    const int wid = __builtin_amdgcn_readfirstlane(tid >> 6), lane = tid & 63, r32 = lane & 31, hi = lane >> 5;
    const unsigned lbase = (unsigned)lds_addr(lds);
    LAS float* al_l = (LAS float*)(uintptr_t)(lbase + AT_WS + wid * 256);
    const int vb0 = (int)lbase + v_rd_base(lane);
    const int NT = t_hi - t_lo; if (NT <= 0) return;
    int ko[2], vo[2];
#pragma unroll
    for (int j = 0; j < 2; ++j) { const int pz = j * 512 + tid; const int row = pz >> 4, ch = (pz & 15) ^ (row & 15); ko[j] = row * ld + ch * 8;
        const int kk = (pz >> 7) * 8 + ((pz & 31) >> 2), k = (kk & ~0xC) | ((kk & 4) << 1) | ((kk & 8) >> 1), c0 = ((pz >> 5) & 3) * 32 + (pz & 3) * 8; vo[j] = k * ld + c0; }
#define S3_DMA(i, kbo, vbo) do { const bf16_t* kt_ = Kg + (size_t)((t_lo + (i)) * 64) * ld; const bf16_t* vt_ = Vg + (size_t)((t_lo + (i)) * 64) * ld; \
        _Pragma("unroll") for (int j = 0; j < 2; ++j) { \
            __builtin_amdgcn_global_load_lds((const unsigned*)(kt_ + ko[j]), (LAS unsigned*)(uintptr_t)(lbase + AT_K + (kbo) + j * 8192 + wid * 1024), 16, 0, 0); \
            __builtin_amdgcn_global_load_lds((const unsigned*)(vt_ + vo[j]), (LAS unsigned*)(uintptr_t)(lbase + (vbo) + j * 8192 + wid * 1024), 16, 0, 0); } } while (0)
    __syncthreads();
    S3_DMA(0, 0u, 0);
    asm volatile("s_waitcnt vmcnt(0)" ::: "memory");
    __syncthreads();
    bf16x8 pa0 = {}, pa1 = {}, pa2 = {}, pa3 = {}; bool prev_act = false;
    int vprev = 0, vcur = 0, vnext = 16384;
    float carry_ = 0.f, mprev_ = 0.f;
    for (int i = 0; i < NT; ++i) {
        const int t = t_lo + i, kb_ = t * 64; const unsigned kcur = (unsigned)(i & 1) * 16384u;
        if (i + 1 < NT && !(var & 8)) S3_DMA(i + 1, (unsigned)((i + 1) & 1) * 16384u, vnext);
        bool act_ = true, on_ = true;
        if (MODE == 1) { const unsigned sw_ = ((const LAS unsigned*)(uintptr_t)(lbase + AT_SEL))[(tq & 63) * 2 + (t >> 5)]; on_ = ((sw_ >> (t & 31)) & 1u) != 0u; act_ = __any(on_); }
        f32x16 p0, p1;
        if (act_) { if (!(var & 1)) qkt_rt(p0, p1, lbase + AT_K + kcur, r32, hi, qr); else { p0 = f32x16{}; p1 = f32x16{}; } }
        if (prev_act && !(var & 2)) pv_tile<0, false>(o, vb0 + vprev, pa0, pa1, pa2, pa3, true);
        if (act_ && !(var & 4)) {
            if (MODE == 2) { if (kb_ + 63 > qlo || kb_ <= qlo + 31 - 512) mask_tile(p0, p1, tq - 4 * hi - kb_, 512u); }
            if (MODE == 1) { if (t == qb) mask_tile(p0, p1, tq - 4 * hi - kb_, 1u << 30); }
            if (MODE == 0) { mask_tile(p0, p1, ((tq - 31) >> 4) - 4 * hi - kb_, 1u << 30); }
            float mn_, alpha_; partialSM(p0, p1, m_reg, mn_, alpha_, MODE == 1 ? on_ : true);
            if (__any(alpha_ < 1.f)) { if (hi == 0) al_l[r32] = alpha_; asm volatile("s_waitcnt lgkmcnt(0)" ::: "memory");
#pragma unroll
                for (int d_ = 0; d_ < 4; ++d_)
#pragma unroll
                    for (int r = 0; r < 16; ++r) o[d_][r] *= al_l[crow(r, hi)]; }
            finishSM(p0, p1, alpha_, l_reg, pa0, pa1, pa2, pa3);
            if (MODE == 0 && ir != nullptr) {
                constexpr float C2i = 1.4426950408889634f * SCALE;
                float s4[8], lastv[8];
#pragma unroll
                for (int g4 = 0; g4 < 4; ++g4) { s4[g4] = (p0[4 * g4] + p0[4 * g4 + 1]) + (p0[4 * g4 + 2] + p0[4 * g4 + 3]); lastv[g4] = p0[4 * g4 + 3];
                    s4[4 + g4] = (p1[4 * g4] + p1[4 * g4 + 1]) + (p1[4 * g4 + 2] + p1[4 * g4 + 3]); lastv[4 + g4] = p1[4 * g4 + 3]; }
                const float cin = carry_ > 0.f ? carry_ * __builtin_amdgcn_exp2f((mprev_ - mn_) * C2i) : 0.f;
#pragma unroll
                for (int gi = 0; gi < 8; ++gi) { const float snd = hi ? (gi > 0 ? lastv[gi - 1] : cin) : lastv[gi]; const float rcv = __shfl_xor(snd, 32);
                    ir[16 * i + 2 * gi + hi] = s4[gi] + rcv; }
                carry_ = lastv[7]; mprev_ = mn_;
                if (i == 0) mt[0] = mn_; else if (i == 1) mt[1] = mn_; else if (i == 2) mt[2] = mn_; else mt[3] = mn_;
            }
        }
        prev_act = act_;
        vprev = vcur; vcur = vnext; vnext = vnext == 32768 ? 0 : vnext + 16384;
        asm volatile("s_waitcnt vmcnt(0)" ::: "memory");
        if (!(var & 128)) __syncthreads();
    }
    if (prev_act) pv_tile<0, false>(o, vb0 + vprev, pa0, pa1, pa2, pa3, true);
#undef S3_DMA
}

template <int MODE>
__device__ __forceinline__ void attn_sweep2(unsigned char* lds, const bf16_t* Kg, const bf16_t* Vg, int ld, int t_lo, int t_hi, const bf16x8 (&qr)[8],
                                            int tq, int qlo, unsigned long long selm, int qb, f32x16 (&o)[4], float& m_reg, float& l_reg) {
    const int tid = threadIdx.x, wid = __builtin_amdgcn_readfirstlane(tid >> 6), lane = tid & 63, r32 = lane & 31, hi = lane >> 5;
    const int sr = tid >> 4, sc = (tid & 15) * 8, vst0 = v_st(sr, sc), vst1 = v_st(32 + sr, sc), kws = KSWZ(sr, sc * 2);
    char* V_lds = (char*)lds; char* K_lds = (char*)lds + AT_K; float* al_l = (float*)(lds + AT_WS) + wid * 64;
    const int vb0 = lds_addr(V_lds) + v_rd_base(lane);
    const int NT = t_hi - t_lo; if (NT <= 0) return;
    bf16x8 st_k0, st_k1, st_v0, st_v1;
#define S2_LOAD(t) do { const bf16_t* kp = Kg + (size_t)((t_lo + (t)) * 64 + sr) * ld + sc; const bf16_t* vp = Vg + (size_t)((t_lo + (t)) * 64 + sr) * ld + sc; \
        st_v0 = *(const bf16x8*)vp; st_v1 = *(const bf16x8*)(vp + (size_t)32 * ld); st_k0 = *(const bf16x8*)kp; st_k1 = *(const bf16x8*)(kp + (size_t)32 * ld); } while (0)
#define S2_WRITE(bf) do { *(bf16x8*)(V_lds + (bf) * SHM_V + vst0) = st_v0; *(bf16x8*)(V_lds + (bf) * SHM_V + vst1) = st_v1; \
        *(bf16x8*)(K_lds + (bf) * SHM_K + kws) = st_k0; *(bf16x8*)(K_lds + (bf) * SHM_K + kws + 32 * 256) = st_k1; } while (0)
#define S2_VMW() asm volatile("s_waitcnt vmcnt(0)" ::: "memory")
#define S2_RESC(a) do { if (__any((a) < 1.f)) { if (hi == 0) al_l[r32] = (a); asm volatile("s_waitcnt lgkmcnt(0)" ::: "memory"); \
        _Pragma("unroll") for (int d_ = 0; d_ < 4; ++d_) _Pragma("unroll") for (int r = 0; r < 16; ++r) o[d_][r] *= al_l[crow(r, hi)]; } } while (0)
#define S2_MASK(PX0, PX1, t) do { const int kb_ = (t_lo + (t)) * 64; \
        if (MODE == 2) { if (kb_ + 63 > qlo || kb_ <= qlo + 31 - 512) mask_tile(PX0, PX1, tq - 4 * hi - kb_, 512u); } \
        if (MODE == 1) { if (t_lo + (t) == qb) mask_tile(PX0, PX1, tq - 4 * hi - kb_, 1u << 30); \
            if (!((selm >> (t_lo + (t))) & 1ull)) { const float NEG_ = -__builtin_inff(); _Pragma("unroll") for (int r = 0; r < 16; ++r) { PX0[r] = NEG_; PX1[r] = NEG_; } } } \
        if (MODE == 0) { mask_tile(PX0, PX1, ((tq - 31) >> 4) - 4 * hi - kb_, 1u << 30); } } while (0)
    f32x16 pA0, pA1, pB0, pB1; float mnA, mnB, alA, alB; bf16x8 pa0, pa1, pa2, pa3;
    __syncthreads();
    S2_LOAD(0); S2_VMW(); S2_WRITE(0); SBAR();
    if (NT > 1) S2_LOAD(1);
    __syncthreads();
    SBAR(); qkt<0, false>(pA0, pA1, K_lds, r32, hi, qr, true);
    S2_MASK(pA0, pA1, 0); partialSM(pA0, pA1, m_reg, mnA, alA);
    if (NT > 1) { S2_VMW(); S2_WRITE(1); }
    __syncthreads();
#define S2_HALF(PX0, PX1, mnX, alX, PY0, PY1, alY, t, KB, VB, SB) do { \
        SBAR(); qkt<KB, false>(PX0, PX1, K_lds, r32, hi, qr, true); \
        finishSM(PY0, PY1, alY, l_reg, pa0, pa1, pa2, pa3); SBAR(); \
        if ((t) + 1 < NT) { S2_LOAD((t) + 1); SBAR(); } \
        pv_tile<VB, false>(o, vb0, pa0, pa1, pa2, pa3, true); S2_MASK(PX0, PX1, (t)); partialSM(PX0, PX1, m_reg, mnX, alX); \
        __syncthreads(); \
        if ((t) + 1 < NT) { S2_VMW(); S2_WRITE(SB); } \
        S2_RESC(alX); __syncthreads(); } while (0)
    for (int t = 1; t + 1 < NT; t += 2) {
        S2_HALF(pB0, pB1, mnB, alB, pA0, pA1, alA, t, 1, 0, 0);
        S2_HALF(pA0, pA1, mnA, alA, pB0, pB1, alB, t + 1, 0, 1, 1);
    }
    const bool even = (NT & 1) == 0;
    if (even) { SBAR(); qkt<1, false>(pB0, pB1, K_lds, r32, hi, qr, true); SBAR(); }
    finishSM(pA0, pA1, alA, l_reg, pa0, pa1, pa2, pa3); SBAR();
    pv_tile<0, false>(o, vb0, pa0, pa1, pa2, pa3, true);
    if (even) { S2_MASK(pB0, pB1, NT - 1); partialSM(pB0, pB1, m_reg, mnB, alB); S2_RESC(alB);
        finishSM(pB0, pB1, alB, l_reg, pa0, pa1, pa2, pa3); SBAR(); pv_tile<1, false>(o, vb0, pa0, pa1, pa2, pa3, true); }
    (void)mnA; (void)mnB;
#undef S2_LOAD
#undef S2_WRITE
#undef S2_VMW
#undef S2_RESC
#undef S2_MASK
#undef S2_HALF
}

#if defined(MK_SWEEP4)
#define ATTN_SWEEP attn_sweep4
#elif defined(MK_SWEEP3)
#define ATTN_SWEEP attn_sweep3
#elif !defined(MK_SWEEP1)
#define ATTN_SWEEP attn_sweep2
#else
#define ATTN_SWEEP attn_sweep
#endif
__device__ __forceinline__ void attn_unit(const Params& p, unsigned char* lds, int b, int g, int qb, int var = 0) {
    int tid = threadIdx.x; asm volatile("" : "+v"(tid));
    const int wid = __builtin_amdgcn_readfirstlane(tid >> 6), lane = tid & 63, r32 = lane & 31, hi = lane >> 5;
    const int hh = wid >> 1, th = wid & 1, tq = qb * 64 + th * 32 + r32, qlo = qb * 64 + th * 32;
    const bf16_t* P = (const bf16_t*)(p.ws + WS_PROJ) + (size_t)b * SEQ * LDP;
    LAS float* al_l = (LAS float*)(uintptr_t)(lds_addr(lds) + AT_WS + wid * 256);
#ifdef MK_ATTPRIO
    if (wid >= 4) __builtin_amdgcn_s_setprio(1);
#endif
    bf16x8 qr[8];
#pragma unroll
    for (int d0 = 0; d0 < 8; ++d0) qr[d0] = *(const bf16x8*)(P + (size_t)tq * LDP + COL_Q + (4 * g + hh) * 128 + d0 * 16 + hi * 8);
    const bf16_t* gp = P + (size_t)tq * LDP + COL_GATE + (4 * g + hh) * 3;
    f32x16 o[4] = {}; float m_reg = -1e30f, l_reg = 0.f;
    const unsigned oacc_b = (unsigned)lds_addr(lds) + AT_IMP + wid * 8192 + r32 * 64;
    unsigned oa[4];
#pragma unroll
    for (int k = 0; k < 4; ++k) oa[k] = oacc_b + ((((2 * k + hi) ^ ((r32 >> 2) & 7))) << 3);
#define AT_BRANCH_END(gatev, FIRST) do { if (var & 32) { m_reg = -1e30f; l_reg = 0.f; break; } const float gs_ = (gatev) * (l_reg > 0.f ? 1.0f / l_reg : 0.f); if (hi == 0) al_l[r32] = gs_; asm volatile("s_waitcnt lgkmcnt(0)" ::: "memory"); \
        _Pragma("unroll") for (int k = 0; k < 4; ++k) { const f32x4 s_ = *(const LAS f32x4*)(al_l + 8 * k + 4 * hi); \
            _Pragma("unroll") for (int d_ = 0; d_ < 4; ++d_) { LAS u32x2* q_ = (LAS u32x2*)(uintptr_t)(oa[k] + d_ * 2048); \
                float v0_ = o[d_][4 * k] * s_[0], v1_ = o[d_][4 * k + 1] * s_[1], v2_ = o[d_][4 * k + 2] * s_[2], v3_ = o[d_][4 * k + 3] * s_[3]; \
                o[d_][4 * k] = 0.f; o[d_][4 * k + 1] = 0.f; o[d_][4 * k + 2] = 0.f; o[d_][4 * k + 3] = 0.f; \
                if (!(FIRST)) { const u32x2 w_ = *q_; v0_ += __uint_as_float(w_.x << 16); v1_ += __uint_as_float(w_.x & 0xffff0000u); v2_ += __uint_as_float(w_.y << 16); v3_ += __uint_as_float(w_.y & 0xffff0000u); } \
                u32x2 n_; n_.x = cvtpk(v0_, v1_); n_.y = cvtpk(v2_, v3_); *q_ = n_; } } \
        m_reg = -1e30f; l_reg = 0.f; } while (0)
    const bf16_t* kc = (const bf16_t*)(p.ws + WS_KC) + (size_t)((b * 2 + g) * 256) * 128; const bf16_t* vc = (const bf16_t*)(p.ws + WS_VC) + (size_t)((b * 2 + g) * 256) * 128;
    const int nct = (4 * qb + 2) / 64 + 1;
    float* imp = (float*)(lds + AT_IMP); unsigned long long* selmask = (unsigned long long*)(lds + AT_SEL);
    float* ir = imp + (hh * 64 + th * 32 + r32) * IMP_LD; float mt[4] = {0.f, 0.f, 0.f, 0.f};
    const bool need_imp = qb >= 16 && !(var & 16);
    if (need_imp) { __syncthreads();
        for (int i = tid; i < 4 * 64 * IMP_LD; i += NTHR) imp[i] = 0.f; }
    TC_BEGIN(21);
    ATTN_SWEEP<0>(lds, kc, vc, 128, 0, nct, qr, tq, qlo, 0ull, qb, o, m_reg, l_reg, 0, need_imp ? ir : nullptr, mt);
    TC_END(21, lds); TC_BEGIN(22);
    const unsigned long long selm = 0ull;
    if (!need_imp) { if (tid < 64) selmask[tid] = (2ull << qb) - 1ull; }
    else {
        constexpr float C2 = 1.4426950408889634f * SCALE; const float inv_l = l_reg > 0.f ? 1.0f / l_reg : 0.f;
#pragma unroll
        for (int ti = 0; ti < 4; ++ti) if (ti < nct) { const float f = __builtin_amdgcn_exp2f((mt[ti] - m_reg) * C2) * inv_l;
#pragma unroll
            for (int gi = 0; gi < 8; ++gi) ir[16 * ti + 2 * gi + hi] *= f; }
        __syncthreads();
        { const int j = lane; const bool cand = j >= 1 && j <= qb - 2; const unsigned long long candm = __ballot(cand);
          unsigned bits[8], T[8];
#pragma unroll
          for (int tt = 0; tt < 8; ++tt) { const int tok = wid * 8 + tt;
              const float v = ((imp[(0 * 64 + tok) * IMP_LD + j] + imp[(1 * 64 + tok) * IMP_LD + j]) + imp[(2 * 64 + tok) * IMP_LD + j]) + imp[(3 * 64 + tok) * IMP_LD + j];
              bits[tt] = __float_as_uint(v) & 0x7fffffffu; T[tt] = 0u; }
#pragma unroll 1
          for (int b = 30; b >= 0; --b) {
#pragma unroll
              for (int tt = 0; tt < 8; ++tt) { const unsigned trial = T[tt] | (1u << b); const unsigned long long m = __ballot(bits[tt] >= trial) & candm; if (__popcll(m) >= 13) T[tt] = trial; } }
#pragma unroll
          for (int tt = 0; tt < 8; ++tt) { const int tok = wid * 8 + tt;
              const unsigned long long gt = __ballot(bits[tt] > T[tt]) & candm, eq = __ballot(bits[tt] == T[tt]) & candm; const int need = 13 - (int)__popcll(gt);
              const int below = (int)__builtin_amdgcn_mbcnt_hi((unsigned)(eq >> 32), __builtin_amdgcn_mbcnt_lo((unsigned)eq, 0u));
              const bool sel = (cand && (bits[tt] > T[tt] || (bits[tt] == T[tt] && below < need))) || j == 0 || j == qb || j == qb - 1;
              const unsigned long long mk = __ballot(sel); if (lane == 0) selmask[tok] = mk; } }
        __syncthreads();
    }
    AT_BRANCH_END(sigmoidf_(bf2f(gp[0])), true);
    TC_END(22, lds); TC_BEGIN(23);
    ATTN_SWEEP<1>(lds, P + COL_KS + g * 128, P + COL_VS + g * 128, LDP, 0, qb + 1, qr, tq, qlo, selm, qb, o, m_reg, l_reg, var);
    TC_END(23, lds); TC_BEGIN(24);
    AT_BRANCH_END(sigmoidf_(bf2f(gp[1])), false);
    ATTN_SWEEP<2>(lds, P + COL_KW + g * 128, P + COL_VW + g * 128, LDP, qb > 8 ? qb - 8 : 0, qb + 1, qr, tq, qlo, 0ull, qb, o, m_reg, l_reg, var);
    TC_END(24, lds); TC_BEGIN(25);
    AT_BRANCH_END(sigmoidf_(bf2f(gp[2])), false);
#undef AT_BRANCH_END
    {
      const int cg = lane & 15; const unsigned tb = (unsigned)lds_addr(lds) + AT_IMP + wid * 8192 + cg * 512;
#pragma unroll
      for (int blk = 0; blk < 2; ++blk) { const int rg = (lane >> 4) + 4 * blk; u32x2 c[8];
#pragma unroll
          for (int j = 0; j < 8; ++j) c[j] = *(const LAS u32x2*)(uintptr_t)(tb + j * 64 + ((rg ^ ((2 * cg + (j >> 2)) & 7)) << 3));
          bf16_t* oc = (bf16_t*)(p.ws + WS_R3) + (size_t)(b * SEQ + qb * 64 + th * 32 + 4 * rg) * 2048 + (4 * g + hh) * 128 + cg * 8;
          u32x4 r0, r1, r2, r3;
#pragma unroll
          for (int m = 0; m < 4; ++m) { const unsigned ax = c[2 * m].x, bx_ = c[2 * m + 1].x, ay = c[2 * m].y, by = c[2 * m + 1].y;
              r0[m] = (ax & 0xffffu) | (bx_ << 16); r1[m] = (ax >> 16) | (bx_ & 0xffff0000u); r2[m] = (ay & 0xffffu) | (by << 16); r3[m] = (ay >> 16) | (by & 0xffff0000u); }
          *(u32x4*)oc = r0; *(u32x4*)(oc + 2048) = r1; *(u32x4*)(oc + 2 * 2048) = r2; *(u32x4*)(oc + 3 * 2048) = r3; } }
    TC_END(25, lds);
#ifdef MK_ATTPRIO
    __builtin_amdgcn_s_setprio(0);
#endif
}
__device__ __forceinline__ void p7_rows_route(const Params& p, unsigned char* lds, bool dry, int part) {
    const int tid = threadIdx.x, lane = tid & 63, wave = tid >> 6, G = gridDim.x, fr = lane & 15, fq = lane >> 4;
    unsigned char* ws = p.ws; const float* mod = (const float*)(ws + WS_MOD);
    const float* x = p.in[0]; const float* gpost = p.in[6]; const float* gpre = p.in[7];
    const bf16_t* y = (const bf16_t*)(ws + WS_R4); bf16_t* h2 = (bf16_t*)(ws + WS_R3);
    float* pA = (float*)lds; float* pB = pA + 2048; float* pC = pB + 2048; float* r2s = (float*)(lds + 98304);
    float* scr = r2s + 64 + wave * (16 * 49);
    unsigned* cnt = (unsigned*)(ws + WS_CTL + CTL_CNT);
    int* toke = (int*)(ws + WS_TOKE); int* tokp = (int*)(ws + WS_TOKP); int* rtok = (int*)(ws + WS_RTOK); float* rwe = (float*)(ws + WS_RWE);
    for (int gi = blockIdx.x; gi < T / 64; gi += G) {
        const int b = (gi * 64) >> 12; const float* md = mod + b * 12288;
        __syncthreads();
        for (int i = tid; i < 2048; i += NTHR) { pA[i] = md[4096 + i] * gpost[i]; pB[i] = gpre[i] * (1.0f + md[8192 + i]); pC[i] = md[6144 + i]; }
        __syncthreads();
        const int row0 = gi * 64 + wave * 8;
        f32x4 xa[8], xb[8]; u32x2 ya[8], yb[8];
#define P7_LOAD(X, Y, row) do { const float* xr_ = x + (size_t)(row) * DM + lane * 4; const bf16_t* yr_ = y + (size_t)(row) * DM + lane * 4; \
        _Pragma("unroll") for (int e = 0; e < 8; ++e) { X[e] = NTLD((const f32x4*)(xr_ + e * 256)); Y[e] = NTLD((const u32x2*)(yr_ + e * 256)); } } while (0)
#define P7_PROC(X, Y, row) do { f32x4 yv[8]; float ss = 0.f; \
        _Pragma("unroll") for (int e = 0; e < 8; ++e) { yv[e] = (f32x4){bflo(Y[e].x), bfhi(Y[e].x), bflo(Y[e].y), bfhi(Y[e].y)}; ss += yv[e][0] * yv[e][0] + yv[e][1] * yv[e][1] + yv[e][2] * yv[e][2] + yv[e][3] * yv[e][3]; } \
        ss = wave_sum(ss); const float r1 = rsqrtf(ss * (1.0f / DM) + EPS); float s2 = 0.f; \
        _Pragma("unroll") for (int e = 0; e < 8; ++e) { const f32x4 av = *(const f32x4*)(pA + e * 256 + lane * 4); const f32x4 x1 = X[e] + av * (yv[e] * r1); yv[e] = x1; \
            *(f32x4*)(p.out + (size_t)(row) * DM + e * 256 + lane * 4) = x1; s2 += x1[0] * x1[0] + x1[1] * x1[1] + x1[2] * x1[2] + x1[3] * x1[3]; } \
        s2 = wave_sum(s2); const float rr = rsqrtf(s2 * (1.0f / DM) + EPS); if (lane == 0) r2s[(row) - gi * 64] = rr; \
        _Pragma("unroll") for (int e = 0; e < 8; ++e) { const f32x4 bv = *(const f32x4*)(pB + e * 256 + lane * 4), cv = *(const f32x4*)(pC + e * 256 + lane * 4); const f32x4 o = yv[e] * rr * bv + cv; \
            u32x2 w; w.x = cvtpk(o[0], o[1]); w.y = cvtpk(o[2], o[3]); *(u32x2*)(h2 + (size_t)(row) * DM + e * 256 + lane * 4) = w; } } while (0)
        if (part & 1) {
        P7_LOAD(xa, ya, row0);
#pragma unroll 1
        for (int j = 0; j < 8; j += 2) { P7_LOAD(xb, yb, row0 + j + 1); P7_PROC(xa, ya, row0 + j); if (j + 2 < 8) P7_LOAD(xa, ya, row0 + j + 2); P7_PROC(xb, yb, row0 + j + 1); }
        }
#undef P7_LOAD
#undef P7_PROC
        __syncthreads();
        if (part & 2) {
            const bf16_t* WRh = (const bf16_t*)(ws + WS_WR) + ((size_t)(b * 64 + wave * 8) * 3 * 64 + lane) * 8; const bf16_t* WRl = WRh + 393216; const float* BR = (const float*)(ws + WS_BR) + b * 48;
            const float* xr = p.out + (size_t)(gi * 64 + fr) * DM + wave * 256 + fq * 8;
            f32x4 acc[4][3] = {};
#pragma unroll 2
            for (int s = 0; s < 8; ++s) { const bf16_t* wh = WRh + (size_t)s * 1536; const bf16_t* wl = WRl + (size_t)s * 1536;
                const bf16x8 h0 = *(const bf16x8*)wh, h1 = *(const bf16x8*)(wh + 512), h2_ = *(const bf16x8*)(wh + 1024), l0 = *(const bf16x8*)wl, l1 = *(const bf16x8*)(wl + 512), l2 = *(const bf16x8*)(wl + 1024);
#pragma unroll
                for (int q = 0; q < 4; ++q) { const f32x4 xa_ = *(const f32x4*)(xr + (size_t)q * 16 * DM + s * 32), xb_ = *(const f32x4*)(xr + (size_t)q * 16 * DM + s * 32 + 4);
                    const bf16x8 xh = pack8(xa_, xb_); f32x4 ra_, rb_;
#pragma unroll
                    for (int j = 0; j < 4; ++j) { ra_[j] = xa_[j] - bf2f((unsigned short)xh[j]); rb_[j] = xb_[j] - bf2f((unsigned short)xh[4 + j]); }
                    const bf16x8 xl = pack8(ra_, rb_);
                    acc[q][0] = __builtin_amdgcn_mfma_f32_16x16x32_bf16(xh, h0, acc[q][0], 0, 0, 0); acc[q][1] = __builtin_amdgcn_mfma_f32_16x16x32_bf16(xh, h1, acc[q][1], 0, 0, 0); acc[q][2] = __builtin_amdgcn_mfma_f32_16x16x32_bf16(xh, h2_, acc[q][2], 0, 0, 0);
                    acc[q][0] = __builtin_amdgcn_mfma_f32_16x16x32_bf16(xl, h0, acc[q][0], 0, 0, 0); acc[q][1] = __builtin_amdgcn_mfma_f32_16x16x32_bf16(xl, h1, acc[q][1], 0, 0, 0); acc[q][2] = __builtin_amdgcn_mfma_f32_16x16x32_bf16(xl, h2_, acc[q][2], 0, 0, 0);
                    acc[q][0] = __builtin_amdgcn_mfma_f32_16x16x32_bf16(xh, l0, acc[q][0], 0, 0, 0); acc[q][1] = __builtin_amdgcn_mfma_f32_16x16x32_bf16(xh, l1, acc[q][1], 0, 0, 0); acc[q][2] = __builtin_amdgcn_mfma_f32_16x16x32_bf16(xh, l2, acc[q][2], 0, 0, 0); } }
            float* psum = (float*)lds;
#pragma unroll
            for (int q = 0; q < 4; ++q)
#pragma unroll
                for (int cb = 0; cb < 3; ++cb) *(f32x4*)(psum + ((wave * 4 + q) * 3 + cb) * 256 + lane * 4) = acc[q][cb];
            int* lh = (int*)(lds + 131072); int* gb = lh + 32;
            if (tid < 32) lh[tid] = 0;
            __syncthreads();
            const int rbl = wave, rb = gi * 4 + rbl;
            int ea = 0, eb = 0, la = 0, lbp = 0; float w1 = 0.f, w2 = 0.f;
            if (wave < 4) { f32x4 a0 = {}, a1 = {}, a2 = {};
#pragma unroll
                for (int w = 0; w < 8; ++w) { a0 += *(const f32x4*)(psum + ((w * 4 + rbl) * 3 + 0) * 256 + lane * 4); a1 += *(const f32x4*)(psum + ((w * 4 + rbl) * 3 + 1) * 256 + lane * 4); a2 += *(const f32x4*)(psum + ((w * 4 + rbl) * 3 + 2) * 256 + lane * 4); }
#pragma unroll
            for (int r = 0; r < 4; ++r) { const int row = fq * 4 + r; const float rr = r2s[rbl * 16 + row];
                scr[row * 49 + fr] = a0[r] * rr + BR[fr]; scr[row * 49 + 16 + fr] = a1[r] * rr + BR[16 + fr]; scr[row * 49 + 32 + fr] = a2[r] * rr + BR[32 + fr]; }
            asm volatile("s_waitcnt lgkmcnt(0)" ::: "memory");
            if (lane < 16) { const float* lg = scr + lane * 49; const int tok = rb * 16 + lane;
                int gs = 0; float gm = lg[0];
#pragma unroll
                for (int i = 1; i < 4; ++i) if (lg[i] > gm) { gm = lg[i]; gs = i; }
                float den = 0.f;
#pragma unroll
                for (int i = 0; i < 4; ++i) den += expf(lg[i] - gm);
                const float pg = 1.0f / den;
                const float* le = lg + 4 + gs * 8; int i1 = 0; float v1 = le[0];
#pragma unroll
                for (int i = 1; i < 8; ++i) if (le[i] > v1) { v1 = le[i]; i1 = i; }
                int i2 = i1 == 0 ? 1 : 0; float v2 = -__builtin_inff();
#pragma unroll
                for (int i = 0; i < 8; ++i) if (i != i1 && le[i] > v2) { v2 = le[i]; i2 = i; }
                const float e2 = expf(v2 - v1); w1 = pg / (1.0f + e2); w2 = pg * e2 / (1.0f + e2);
                ea = gs * 8 + i1; eb = gs * 8 + i2;
                if (dry) { if (w1 == 123.456f) toke[0] = ea + eb; } else { la = atomicAdd(lh + ea, 1); lbp = atomicAdd(lh + eb, 1); } }
            }
            __syncthreads();
            if (tid < 32 && !dry) { const int c_ = lh[tid]; gb[tid] = c_ > 0 ? (int)atomicAdd(cnt + tid, (unsigned)c_) : 0; }
            __syncthreads();
            if (wave < 4 && lane < 16 && !dry) { const int tok = rb * 16 + lane; const int pa = gb[ea] + la, pb = gb[eb] + lbp;
                toke[tok * 2] = ea; toke[tok * 2 + 1] = eb; tokp[tok * 2] = pa; tokp[tok * 2 + 1] = pb;
                rtok[ea * 16384 + pa] = tok; rtok[eb * 16384 + pb] = tok; rwe[ea * 16384 + pa] = w1; rwe[eb * 16384 + pb] = w2; }
        }
    }
}
__device__ __forceinline__ void moe_toff(const Params& p, int* toff) {
    const int tid = threadIdx.x;
    __syncthreads();
    if (tid < 64) { const unsigned* cnt = (const unsigned*)(p.ws + WS_CTL + CTL_CNT);
        const int c = tid < 32 ? (int)__hip_atomic_load(cnt + tid, __ATOMIC_RELAXED, __HIP_MEMORY_SCOPE_AGENT) : 0; const int nt = (c + 255) >> 8;
        int incl = nt;
#pragma unroll
        for (int o = 1; o < 32; o <<= 1) { const int v = __shfl_up(incl, o); if ((tid & 63) >= o) incl += v; }
        if (tid < 32) { toff[tid] = incl - nt; toff[48 + tid] = c; } if (tid == 31) toff[32] = incl; }
    __syncthreads();
    const int ntile = toff[32];
    if (tid < 160) { int e = 0; bool tiny = false;
        if (tid < ntile) { while (toff[e + 1] <= tid) ++e; tiny = toff[48 + e] - (tid - toff[e]) * 256 <= 128; toff[256 + tid] = e; }
#ifdef MK_ORDPAR
        (void)tiny; toff[416 + tid] = (tid < ntile && (e & 1) == 0) ? 1 : 0; }
    __syncthreads();
    if (tid < ntile) { int nev = 0, before_ev = 0;
        for (int k = 0; k < ntile; ++k) { const int f = toff[416 + k]; nev += f; if (k < tid) before_ev += f; }
        const bool ev = toff[416 + tid] != 0; const int nod = ntile - nev, mn = nev < nod ? nev : nod; const int k = ev ? before_ev : tid - before_ev;
        const int pos = k < mn ? 2 * k + (ev ? 0 : 1) : 2 * mn + (k - mn);
        toff[96 + pos] = tid; }
    __syncthreads();
#else
        toff[416 + tid] = (tid < ntile && !tiny) ? 1 : 0; }
    __syncthreads();
    if (tid < ntile) { int nfull = 0, before_full = 0;
        for (int k = 0; k < ntile; ++k) { const int f = toff[416 + k]; nfull += f; if (k < tid) before_full += f; }
        const bool full = toff[416 + tid] != 0; const int pos = full ? before_full : nfull + (tid - before_full);
        toff[96 + pos] = tid; }
    __syncthreads();
#endif
}
__device__ __forceinline__ void p11_final(const Params& p, const int* toff, unsigned char* lds, bool dry) {
    const int tid = threadIdx.x, lane = tid & 63, wave = tid >> 6, G = gridDim.x;
    unsigned char* ws = p.ws; const float* mod = (const float*)(ws + WS_MOD); const float* gpost = p.in[8];
    const bf16_t* yd = (const bf16_t*)(ws + WS_YD); const int* toke = (const int*)(ws + WS_TOKE); const int* tokp = (const int*)(ws + WS_TOKP);
    float* pD = (float*)lds;
    for (int gi = blockIdx.x; gi < T / 64; gi += G) {
        const int b = (gi * 64) >> 12; const float* md = mod + b * 12288;
        __syncthreads();
        for (int i = tid; i < 2048; i += NTHR) pD[i] = md[10240 + i] * gpost[i];
        __syncthreads();
        const int row0 = gi * 64 + wave * 8;
        int ra0, rb0, ra1, rb1;
#define P11_IDX(j_, RA, RB) do { const int t2_ = (row0 + (j_)) * 2; RA = toff[toke[t2_]] * 256 + tokp[t2_]; RB = toff[toke[t2_ + 1]] * 256 + tokp[t2_ + 1]; } while (0)
        f32x4 xa[8], xb[8]; u32x2 ya0[8], ya1[8], yb0[8], yb1[8];
#define P11_LOAD(X, Y0, Y1, j, RA, RB) do { const float* xr_ = p.out + (size_t)(row0 + (j)) * DM + lane * 4; const bf16_t* y0_ = yd + (size_t)(RA) * DM + lane * 4; const bf16_t* y1_ = yd + (size_t)(RB) * DM + lane * 4; \
        _Pragma("unroll") for (int e = 0; e < 8; ++e) { X[e] = NTLD((const f32x4*)(xr_ + e * 256)); Y0[e] = NTLD((const u32x2*)(y0_ + e * 256)); Y1[e] = NTLD((const u32x2*)(y1_ + e * 256)); } } while (0)
#define P11_PROC(X, Y0, Y1, j) do { f32x4 yv[8]; float ss = 0.f; \
        _Pragma("unroll") for (int e = 0; e < 8; ++e) { yv[e] = (f32x4){bflo(Y0[e].x) + bflo(Y1[e].x), bfhi(Y0[e].x) + bfhi(Y1[e].x), bflo(Y0[e].y) + bflo(Y1[e].y), bfhi(Y0[e].y) + bfhi(Y1[e].y)}; \
            ss += yv[e][0] * yv[e][0] + yv[e][1] * yv[e][1] + yv[e][2] * yv[e][2] + yv[e][3] * yv[e][3]; } \
        ss = wave_sum(ss); const float r1 = rsqrtf(ss * (1.0f / DM) + EPS); \
        _Pragma("unroll") for (int e = 0; e < 8; ++e) { const f32x4 dv = *(const f32x4*)(pD + e * 256 + lane * 4); const f32x4 o_ = X[e] + dv * (yv[e] * r1); if (!dry) NTST(o_, (f32x4*)(p.out + (size_t)(row0 + (j)) * DM + e * 256 + lane * 4)); else if (o_[0] == 123.456f) *(float*)(p.ws + WS_END) = o_[1]; } } while (0)
        P11_IDX(0, ra0, rb0); P11_IDX(1, ra1, rb1);
        P11_LOAD(xa, ya0, ya1, 0, ra0, rb0);
#pragma unroll 1
        for (int j = 0; j < 8; j += 2) {
            P11_LOAD(xb, yb0, yb1, j + 1, ra1, rb1);
            if (j + 2 < 8) { P11_IDX(j + 2, ra0, rb0); P11_IDX(j + 3, ra1, rb1); }
            P11_PROC(xa, ya0, ya1, j);
            if (j + 2 < 8) P11_LOAD(xa, ya0, ya1, j + 2, ra0, rb0);
            P11_PROC(xb, yb0, yb1, j + 1); }
#undef P11_IDX
#undef P11_LOAD
#undef P11_PROC
    }
}
#ifdef MK_CODEPF
template <int NK> __device__ __forceinline__ void code_prefetch() {
    if (threadIdx.x < 64) {
        unsigned long long pc; asm volatile("s_getpc_b64 %0" : "=s"(pc));
        const unsigned long long a = (pc & ~127ull) + (unsigned long long)threadIdx.x * 128ull;
        unsigned v0, v1, v2, v3, v4, v5;
        if (NK >= 6) asm volatile("global_load_dword %0, %6, off\n\tglobal_load_dword %1, %7, off\n\tglobal_load_dword %2, %8, off\n\tglobal_load_dword %3, %9, off\n\tglobal_load_dword %4, %10, off\n\tglobal_load_dword %5, %11, off\n\ts_waitcnt vmcnt(0)"
            : "=&v"(v0), "=&v"(v1), "=&v"(v2), "=&v"(v3), "=&v"(v4), "=&v"(v5) : "v"(a), "v"(a + 8192ull), "v"(a + 16384ull), "v"(a + 24576ull), "v"(a + 32768ull), "v"(a + 40960ull) : "memory");
        else if (NK >= 4) asm volatile("global_load_dword %0, %4, off\n\tglobal_load_dword %1, %5, off\n\tglobal_load_dword %2, %6, off\n\tglobal_load_dword %3, %7, off\n\ts_waitcnt vmcnt(0)"
            : "=&v"(v0), "=&v"(v1), "=&v"(v2), "=&v"(v3) : "v"(a), "v"(a + 8192ull), "v"(a + 16384ull), "v"(a + 24576ull) : "memory");
        else asm volatile("global_load_dword %0, %2, off\n\tglobal_load_dword %1, %3, off\n\ts_waitcnt vmcnt(0)" : "=&v"(v0), "=&v"(v1) : "v"(a), "v"(a + 8192ull) : "memory");
    }
}
#define CODEPF(n) code_prefetch<n>()
#else
#define CODEPF(n) do {} while (0)
#endif
#ifndef MK_WGM2
#define MK_WGM2 pg8::WGM
#endif
#ifndef MK_ANT
#define MK_ANT false
#endif
#ifndef MK_BNT
#define MK_BNT false
#endif
constexpr int N_PHASES = 11;
#ifndef MK_DN_P4
#define MK_DN_P4 0
#endif
#ifndef MK_DN_P2
#define MK_DN_P2 0
#endif
#ifdef MK_XMOE
#define XPOSE_DN_P4(w_, nw_) xpose_moe<1>(p, lds, (w_), (nw_), 0, MK_DN_P4)
#else
#define XPOSE_DN_P4(w_, nw_) do {} while (0)
#endif
__global__ void __launch_bounds__(NTHR, 2) mk_fwd(Params p) {
    extern __shared__ __attribute__((aligned(16))) unsigned char lds[];
    const int tid = threadIdx.x, G = gridDim.x, bx = blockIdx.x;
    for (int u = tid; u < (LDS_BYTES - MISC_OFF) / 4; u += NTHR) ((unsigned*)(lds + MISC_OFF))[u] = 0u;
    __syncthreads();
    XcdBarrier bar = xcd_barrier_post((unsigned*)(p.ws + WS_CTL), (volatile LAS unsigned*)(lds + MISC_OFF));
    int* toff = (int*)(lds + MISC_OFF + 64);
    unsigned char* ws = p.ws;
    const int lo = p.ph_lo, hi = p.ph_hi;
#ifndef MK_ONLY
#define MK_ONLY -1
#endif
#define IN(k) ((MK_ONLY < 0 || MK_ONLY == (k)) && lo <= (k) && (k) < hi)
#ifndef MK_BAR2
#define MK_BAR2 0
#endif
#ifndef MK_TMODE
#define MK_TMODE 0
#endif
#if MK_TMODE
    volatile unsigned long long* tst = (volatile unsigned long long*)(lds + MISC_OFF + 3072);
    if (tid == 0) { tst[0] = wall_clock64(); tst[1] = 0ull; }
#define SEAM(k) do { if (IN(k) && IN((k) + 1)) { unsigned long long ta_ = 0ull; if (tid == 0) ta_ = wall_clock64(); xcd_barrier(bar); \
        if (tid == 0) { const unsigned long long te_ = wall_clock64(); if (MK_TMODE != 4 && ((MK_TMASK >> (k)) & 1)) tst[1] += (MK_TMODE == 1) ? te_ - ta_ : ((MK_TMODE == 2) ? ta_ - tst[0] : te_ - tst[0]); tst[0] = te_; } } } while (0)
#else
#define SEAM(k) do { if (IN(k) && IN((k) + 1)) { xcd_barrier(bar); if (MK_BAR2) xcd_barrier(bar); } } while (0)
#endif
#ifndef MK_DUPMASK
#define MK_DUPMASK 0
#endif
#define REP(k) for (int rep_ = 0; rep_ < (((MK_DUPMASK >> (k)) & 1) ? 2 : 1); ++rep_)
#ifdef MK_NOBAR0
    if (IN(0)) REP(0) { p0_prologue(p, lds); } if (!(IN(0) && IN(1))) { SEAM(0); } else __syncthreads();
#else
    if (IN(0)) REP(0) { p0_prologue(p, lds); } SEAM(0);
#endif
    if (IN(1)) REP(1) { CODEPF(2); p1_norm1(p, lds); } SEAM(1);
    if (IN(2)) REP(2) { CODEPF(2); pg8::Gemm g{(const bf16_t*)(ws + WS_R3), (const bf16_t*)(ws + WS_W1T), T, 6912, 2048}; pg8::StaticOrder S; S.init(T, 6912, G, bx);
        pg8::EpiProj E{(bf16_t*)(ws + WS_PROJ), LDP, 0x15Fu  , (const float*)(ws + WS_COS), (const float*)(ws + WS_SIN)};
#ifdef MK_XMOE
#define XPOSE_GU(w_, nw_) do { xpose_moe<0>(p, lds, (w_), (nw_), 0, XT_GU_TAIL1); xpose_moe<1>(p, lds, (w_), (nw_), MK_DN_P4, MK_DN_P4 + MK_DN_P2); } while (0)
#define XPOSE_DN(w_, nw_) xpose_moe<1>(p, lds, (w_), (nw_), MK_DN_P4 + MK_DN_P2, XT_MOE)
#else
#define XPOSE_GU(w_, nw_) XPOSE1(p, lds, XT_GU0, XT_GU0 + XT_GU_TAIL1, (w_), (nw_), true)
#ifdef MK_DNNT
#define XPOSE_DN(w_, nw_) XPOSE1(p, lds, XT_DN0, XT_CW0, (w_), (nw_), true)
#else
#define XPOSE_DN(w_, nw_) XPOSE1(p, lds, XT_DN0, XT_CW0, (w_), (nw_))
#endif
#endif
#ifdef MK_P2SPLIT
        { const int rem = S.nwg % G, nfull = S.nwg / G; const bool conv = rem != 0 && bx >= rem; const int split = conv ? (bx - rem) % (nfull + 1) : 1 << 20;
#pragma unroll 1
          for (int part = 0; part < 2; ++part) { pg8::RangeOrder<pg8::StaticOrder> R{S, part ? split : 0, part ? (1 << 20) : split};
              pg8::gemm_phase<pg8::EpiProj, pg8::RangeOrder<pg8::StaticOrder>, true, true>((PG8_LAS unsigned char*)lds, g, R, E);
              if (part == 0) { TC_BEGIN(7); if (conv) XPOSE_GU(bx - rem, G - rem); else if (rem == 0) XPOSE_GU(bx, G); TC_END(7, lds); } } }
#else
        pg8::gemm_phase<pg8::EpiProj, pg8::StaticOrder, true, true>((PG8_LAS unsigned char*)lds, g, S, E);
        { const int rem = S.nwg % G; if (rem != 0 && bx >= rem) { XPOSE_GU(bx - rem, G - rem); routing_weights(p, lds, bx - rem, G - rem); } else if (rem == 0) { XPOSE_GU(bx, G); routing_weights(p, lds, bx, G); } }
#endif
        } SEAM(2);
#ifndef MK_DRY
#define MK_DRY 0
#endif
    const bool dryok = p.ph_hi < 1000;
    if (IN(3)) { CODEPF(2); for (int rp_ = (MK_DRY & 2) ? 0 : 1; rp_ < 2; ++rp_) hgrn_h1_phase(p, lds, rp_ == 0 && dryok); } SEAM(3);
#ifndef MK_P4DUP
#define MK_P4DUP 0
#endif
    if (IN(4)) REP(4) { CODEPF(4);
        if (G >= 2) { if ((bx & 1) == 0) { TC_BEGIN(13); for (int u = bx >> 1; u < 128; u += (G + 1) >> 1) compress_unit(p, lds, u); TC_END(13, lds); } else { TC_BEGIN(14); hgrn_h2_scan(p, bx >> 1, G >> 1); TC_END(14, lds); XPOSE_DN_P4(bx >> 1, G >> 1); } }
        else { for (int u = 0; u < 128; ++u) compress_unit(p, lds, u); hgrn_h2_scan(p, 0, 1); XPOSE_DN_P4(0, 1); } } SEAM(4);
#ifndef MK_P5DUP
#define MK_P5DUP 0
#endif
#ifndef MK_AVAR
#define MK_AVAR 0
#endif
    if (IN(5)) REP(5) { CODEPF(6);
        { const int pos_ = bx % 3;
#pragma unroll 1
          for (int st_ = 0; st_ < 3; ++st_) {
              if (st_ == pos_) {
#ifndef NO_H3
                  hgrn_h3_phase(p, lds);
#endif
                  __syncthreads();
#ifdef MK_GU_P5
#ifdef MK_GU_SKEW
                  if (G == 256 && XT_GU_TAIL1 == 768) { const int cls_ = bx < 64 ? 0 : (bx < 128 ? 1 : 2);
                      xpose_moe<0>(p, lds, cls_ == 0 ? bx : (cls_ == 1 ? bx - 64 : bx - 128), cls_ == 2 ? 128 : 64, cls_ == 0 ? 768 : (cls_ == 1 ? 1920 : 2816), cls_ == 0 ? 1920 : (cls_ == 1 ? 2816 : 4096)); }
                  else
#endif
                  xpose_moe<0>(p, lds, bx, G, XT_GU_TAIL1, 2 * XT_MOE);
#endif
#ifdef MK_DN_P5
                  xpose_moe<1>(p, lds, bx, G, 0, XT_MOE);
#endif
#ifdef MK_GEMV4
                  { gemv_silu_table(p, lds); for (int uu = bx; uu < 256; uu += G) { const int sidx = uu >> 2, q = uu & 3; gemv_part(p, lds, ((sidx >> 5) ? 5 : 2) * 32 + (sidx & 31), q); } }
#endif
#ifdef MK_WOUT_P5
                  xpose_tiles(p, lds, XT_WIN, XT_GU0, bx, G);
#endif
              }
              if (st_ < 2) { for (int it = bx; it < 256; it += G) { const int bg = it & 7, pr = it >> 3; attn_unit(p, lds, bg >> 1, bg & 1, st_ ? 63 - pr : pr, 0); } __syncthreads(); } } } } SEAM(5);
    if (IN(6)) REP(6) { CODEPF(2); pg8::Gemm g{(const bf16_t*)(ws + WS_R3), (const bf16_t*)(ws + WS_W2T), T, 2048, 2048}; pg8::StaticOrder S; S.init(T, 2048, G, bx, MK_WGM2);
        pg8::EpiBf16 E{(bf16_t*)(ws + WS_R4), 2048, 7};
        pg8::gemm_phase<pg8::EpiBf16, pg8::StaticOrder, true, true>((PG8_LAS unsigned char*)lds, g, S, E); } SEAM(6);
    if (IN(7)) { CODEPF(2); for (int rp_ = (MK_DRY & (4 | 16 | 32)) ? 0 : 1; rp_ < 2; ++rp_) p7_rows_route(p, lds, rp_ == 0 && dryok, (rp_ == 0 && dryok) ? ((MK_DRY & 16) ? 1 : ((MK_DRY & 32) ? 2 : 3)) : 3); } SEAM(7);
    if (IN(8)) REP(8) { CODEPF(2); moe_toff(p, toff);
        pg8::Gemm g{(const bf16_t*)(ws + WS_R3), (const bf16_t*)(ws + WS_WGU), T, 32 * 1024, 2048};
        pg8::EpiGateUp E{(bf16_t*)(ws + WS_HID), (const float*)(ws + WS_RWE), (const PG8_LAS int*)toff};
        { const int total8_ = toff[32] * 4;
#ifdef MK_P8NG
          int ng_ = (((total8_ + 2) / 3) + 7) & ~7; ng_ = ng_ < 192 ? 192 : ng_; const bool split_ = ng_ < G;
#else
          const int ng_ = G; const bool split_ = false;
#endif
          const int Gg_ = split_ ? ng_ : G;
          if (bx < Gg_) { pg8::MoeOrder S{(const PG8_LAS int*)toff, (const int*)(ws + WS_RTOK), 4, Gg_, bx};
#ifdef MK_HALFSKIP
              pg8::gemm_phase<pg8::EpiGateUp, pg8::MoeOrder, true, true, true, true>((PG8_LAS unsigned char*)lds, g, S, E); }
#else
              pg8::gemm_phase<pg8::EpiGateUp, pg8::MoeOrder, true, true, true>((PG8_LAS unsigned char*)lds, g, S, E); }
#endif
          const int rem_ = total8_ % G; const int cw_ = split_ ? bx - ng_ : (rem_ != 0 ? bx - rem_ : bx), cn_ = split_ ? G - ng_ : (rem_ != 0 ? G - rem_ : G);
#ifndef MK_DN_P5
          if (cw_ >= 0) XPOSE_DN(cw_, cn_);
#else
          (void)cw_; (void)cn_;
#endif
          } } SEAM(8);
    if (IN(9)) REP(9) { CODEPF(2); if (!IN(8)) moe_toff(p, toff);
        pg8::Gemm g{(const bf16_t*)(ws + WS_HID), (const bf16_t*)(ws + WS_WD), 40960, 32 * 2048, 512}; pg8::MoeOrder S{(const PG8_LAS int*)toff, (const int*)(ws + WS_RTOK), 8, G, bx};
        pg8::EpiBf16 E{(bf16_t*)(ws + WS_YD), 2048, 7};
#ifdef MK_HALFSKIP
        pg8::gemm_phase<pg8::EpiBf16, pg8::MoeOrder, true, true, false, true>((PG8_LAS unsigned char*)lds, g, S, E); } SEAM(9);
#else
        pg8::gemm_phase<pg8::EpiBf16, pg8::MoeOrder, true, true>((PG8_LAS unsigned char*)lds, g, S, E); } SEAM(9);
#endif
    if (IN(10)) REP(10) { CODEPF(2); if (!IN(8)) moe_toff(p, toff); for (int rp_ = (MK_DRY & 8) ? 0 : 1; rp_ < 2; ++rp_) p11_final(p, toff, lds, rp_ == 0 && dryok); }
#if MK_TMODE
    { unsigned long long* tot = (unsigned long long*)(p.ws + WS_CTL + 24576);
      if (tid == 0) { const unsigned long long te_ = wall_clock64(); if (MK_TMODE != 4 && ((MK_TMASK >> 10) & 1)) tst[1] += (MK_TMODE == 1) ? 0ull : te_ - tst[0];
          if (MK_TMODE != 3 || bx == 0) atomicAdd(tot, tst[1]); }
      xcd_barrier(bar);
      if (tid == 0) { const unsigned long long total = __hip_atomic_load(tot, __ATOMIC_RELAXED, __HIP_MEMORY_SCOPE_AGENT); const unsigned long long target = (unsigned long long)MK_TK * (MK_TMODE == 3 ? total : total / (unsigned long long)(MK_TMODE == 4 ? MK_TMASK : G));
          const unsigned long long t0 = wall_clock64(); unsigned sp = 0; while (wall_clock64() - t0 < target && ++sp < (1u << 24)) __builtin_amdgcn_s_sleep(8); }
      __syncthreads(); }
#endif
#undef IN
#undef SEAM
}
}

#ifndef MK_MULTI
#define MK_MULTI 0
#endif
extern "C" void kernel_launch(void* const* d_in, const int* in_sizes, int n_in, void* d_out, int out_size, void* d_ws, size_t ws_size, hipStream_t stream) {
    using namespace mk;
    static int grid = 0;
    if (grid == 0) {
        if (n_in != 26 || out_size != T * DM || ws_size < WS_END) { fprintf(stderr, "kernel_launch: unexpected shapes (n_in %d out %d ws %zu need %zu)\n", n_in, out_size, ws_size, (size_t)WS_END); grid = -1; return; }
        int dev = 0, cus = 0, per_cu = 0;
        if (hipGetDevice(&dev) != hipSuccess || hipDeviceGetAttribute(&cus, hipDeviceAttributeMultiprocessorCount, dev) != hipSuccess) { grid = -1; return; }
        if (hipFuncSetAttribute((const void*)mk_fwd, hipFuncAttributeMaxDynamicSharedMemorySize, LDS_BYTES) != hipSuccess) { fprintf(stderr, "kernel_launch: hipFuncSetAttribute failed\n"); grid = -1; return; }
        if (hipOccupancyMaxActiveBlocksPerMultiprocessor(&per_cu, (const void*)mk_fwd, NTHR, LDS_BYTES) != hipSuccess || per_cu < 1) fprintf(stderr, "kernel_launch: occupancy query says %d\n", per_cu);
        (void)hipGetLastError();
        grid = cus;
    }
    if (grid < 0) return;
    (void)hipMemsetAsync((char*)d_ws + WS_CTL, 0, CTL_BYTES, stream);
    Params p{};
    for (int i = 0; i < 26; ++i) p.in[i] = (const float*)d_in[i];
    p.out = (float*)d_out; p.ws = (unsigned char*)d_ws;
#if MK_MULTI
#ifndef MK_EXTRAMASK
#define MK_EXTRAMASK 0
#endif
    for (int ph = 0; ph < N_PHASES; ++ph) { p.ph_lo = ph; p.ph_hi = ph + 1; hipLaunchKernelGGL(mk_fwd, dim3(grid), dim3(NTHR), LDS_BYTES, stream, p);
        if ((MK_EXTRAMASK >> ph) & 1) hipLaunchKernelGGL(mk_fwd, dim3(grid), dim3(NTHR), LDS_BYTES, stream, p); }
#else
    p.ph_lo = 0; p.ph_hi = N_PHASES; hipLaunchKernelGGL(mk_fwd, dim3(grid), dim3(NTHR), LDS_BYTES, stream, p);
#endif
}
```
